# Optimizing an MI355X kernel written in HIP

```python
import math
import jax, jax.numpy as jnp
from jax import lax
import numpy as np

D_MODEL = 2048
BATCH = 4
SEQ = 8192
DEPTH = 1

D_SSM = 1024
SSM_GROUP = 16
N_SSM_GROUPS = D_SSM // SSM_GROUP
SSM_STATE = 64
DT_MIN = 0.001
DT_MAX = 0.1
N_Q_HEADS = 16
N_KV_HEADS = 4
HEAD_DIM = 64
Q_PER_KV = N_Q_HEADS // N_KV_HEADS
D_ATTN = N_Q_HEADS * HEAD_DIM
D_KV = N_KV_HEADS * HEAD_DIM
WINDOW = 128
BLOCK = 128
N_BUCKETS = 32
MAX_DISTANCE = 128
N_BRANCHES = 2
D_IN = D_SSM + D_SSM + D_ATTN + D_KV + D_KV + D_ATTN + N_BRANCHES * D_MODEL
DEEPNORM_ALPHA = (2.0 * DEPTH) ** 0.25
DEEPNORM_BETA = (8.0 * DEPTH) ** -0.25
LN_EPS = 1e-5
NEG_INF = -1e30

kernel_name = "hybrid_s5_swa_sink_gated_deepnorm"


def _split_columns(proj):
    sizes = (D_SSM, D_SSM, D_ATTN, D_KV, D_KV, D_ATTN, N_BRANCHES * D_MODEL)
    points = []
    acc = 0
    for s in sizes[:-1]:
        acc += s
        points.append(acc)
    return jnp.split(proj, points, axis=-1)


def _layer_norm(x, gain, bias):
    xf = x.astype(jnp.float32)
    mu = jnp.mean(xf, axis=-1, keepdims=True)
    var = jnp.mean(jnp.square(xf - mu), axis=-1, keepdims=True)
    y = (xf - mu) * lax.rsqrt(var + LN_EPS) * gain.astype(jnp.float32) + bias.astype(jnp.float32)
    return y.astype(x.dtype)


def _t5_causal_bucket(dist):
    max_exact = N_BUCKETS // 2
    is_small = dist < max_exact
    d = jnp.maximum(dist, 1).astype(jnp.float32)
    large = max_exact + (jnp.log(d / max_exact) / math.log(MAX_DISTANCE / max_exact)
                         * (N_BUCKETS - max_exact)).astype(jnp.int32)
    large = jnp.minimum(large, N_BUCKETS - 1)
    return jnp.where(is_small, dist, large)


def _band_bias_and_mask(rel_bias_table, n_blocks):
    i = jnp.arange(BLOCK)[:, None]
    j = jnp.arange(2 * BLOCK)[None, :]
    dist = BLOCK + i - j
    band_ok = (dist >= 0) & (dist < WINDOW)
    bucket = _t5_causal_bucket(jnp.clip(dist, 0, None))
    bias = rel_bias_table.astype(jnp.float32)[bucket]
    bias = jnp.transpose(bias, (2, 0, 1)).reshape(N_KV_HEADS, Q_PER_KV, BLOCK, 2 * BLOCK)
    n = jnp.arange(n_blocks)[:, None, None]
    key_abs = n * BLOCK - BLOCK + j[None]
    mask = band_ok[None] & (key_abs >= 0)
    return bias, mask[None, :, None, None]


def _sliding_window_gqa(q, k, v, sinks, rel_bias_table):
    b, s, _ = q.shape
    nb = s // BLOCK
    q = q.reshape(b, nb, BLOCK, N_KV_HEADS, Q_PER_KV, HEAD_DIM)

    def band(t):
        t = t.reshape(b, s, N_KV_HEADS, HEAD_DIM)
        t = jnp.pad(t, ((0, 0), (BLOCK, 0), (0, 0), (0, 0))).reshape(b, nb + 1, BLOCK, N_KV_HEADS, HEAD_DIM)
        return jnp.concatenate([t[:, :-1], t[:, 1:]], axis=2)

    kb, vb = band(k), band(v)
    bias, mask = _band_bias_and_mask(rel_bias_table, nb)
    logits = jnp.einsum("bnqkgd,bnskd->bnkgqs", q, kb).astype(jnp.float32) * (HEAD_DIM ** -0.5)
    logits = jnp.where(mask, logits + bias, NEG_INF)
    sink = sinks.astype(jnp.float32).reshape(N_KV_HEADS, Q_PER_KV)[None, None, :, :, None, None]
    m = jnp.maximum(jnp.max(logits, axis=-1, keepdims=True), sink)
    p = jnp.exp(logits - m)
    p = p / (jnp.sum(p, axis=-1, keepdims=True) + jnp.exp(sink - m))
    out = jnp.einsum("bnkgqs,bnskd->bnqkgd", p.astype(vb.dtype), vb)
    return out.reshape(b, s, D_ATTN)


def _s5_scan_op(e1, e2):
    a1, b1 = e1
    a2, b2 = e2
    return a1 * a2, a2 * b1 + b2


def _s5_ssm(u, lam_re, lam_im, b_re, b_im, c_re, c_im, d_skip, log_step):
    b, s, _ = u.shape
    f32 = jnp.float32
    step = jnp.exp(log_step.astype(f32))[:, None]
    lam = lax.complex(lam_re.astype(f32), lam_im.astype(f32))
    lam_bar = jnp.exp(lam * step)
    b_cplx = lax.complex(b_re.astype(f32), b_im.astype(f32))
    b_bar = ((lam_bar - 1.0) / lam)[..., None] * b_cplx
    ug = u.astype(f32).reshape(b, s, N_SSM_GROUPS, SSM_GROUP)
    bu = lax.complex(jnp.einsum("bsgh,gph->sbgp", ug, jnp.real(b_bar)),
                     jnp.einsum("bsgh,gph->sbgp", ug, jnp.imag(b_bar)))
    a = jnp.broadcast_to(lam_bar[None, None], (s, 1, N_SSM_GROUPS, SSM_STATE))
    _, states = lax.associative_scan(_s5_scan_op, (a, bu), axis=0)
    y = (jnp.einsum("sbgp,ghp->bsgh", jnp.real(states), c_re.astype(f32))
         - jnp.einsum("sbgp,ghp->bsgh", jnp.imag(states), c_im.astype(f32)))
    y = y + d_skip.astype(f32).reshape(N_SSM_GROUPS, SSM_GROUP) * ug
    return y.reshape(b, s, D_SSM)


def setup_inputs(seed: int = 0) -> dict:
    key = jax.random.key(seed)
    ks = jax.random.split(key, 20)
    f32 = jnp.float32
    x = jax.random.normal(ks[0], (BATCH, SEQ, D_MODEL), f32)
    w_in = jax.random.normal(ks[1], (DEPTH, D_MODEL, D_IN), f32) * D_MODEL ** -0.5
    n_idx = jnp.arange(SSM_STATE, dtype=f32)
    ssm_lambda_re = -0.5 + 0.01 * jax.random.normal(ks[2], (DEPTH, N_SSM_GROUPS, SSM_STATE), f32)
    ssm_lambda_im = math.pi * n_idx + 0.01 * jax.random.normal(ks[3], (DEPTH, N_SSM_GROUPS, SSM_STATE), f32)
    ssm_b_re = jax.random.normal(ks[4], (DEPTH, N_SSM_GROUPS, SSM_STATE, SSM_GROUP), f32) * (2.0 * SSM_GROUP) ** -0.5
    ssm_b_im = jax.random.normal(ks[5], (DEPTH, N_SSM_GROUPS, SSM_STATE, SSM_GROUP), f32) * (2.0 * SSM_GROUP) ** -0.5
    ssm_c_re = jax.random.normal(ks[6], (DEPTH, N_SSM_GROUPS, SSM_GROUP, SSM_STATE), f32) * SSM_STATE ** -0.5
    ssm_c_im = jax.random.normal(ks[7], (DEPTH, N_SSM_GROUPS, SSM_GROUP, SSM_STATE), f32) * SSM_STATE ** -0.5
    ssm_d = jax.random.normal(ks[8], (DEPTH, D_SSM), f32)
    ssm_log_step = jax.random.uniform(ks[9], (DEPTH, N_SSM_GROUPS), f32,
                                      minval=math.log(DT_MIN), maxval=math.log(DT_MAX))
    w_glu = jax.random.normal(ks[10], (DEPTH, D_SSM, 2 * D_SSM), f32) * D_SSM ** -0.5
    attn_sinks = jax.random.normal(ks[11], (DEPTH, N_Q_HEADS), f32)
    rel_bias_table = 0.5 * jax.random.normal(ks[12], (N_BUCKETS, N_Q_HEADS), f32)
    w_branch_ssm = jax.random.normal(ks[13], (DEPTH, D_SSM, D_MODEL), f32) * D_SSM ** -0.5 * DEEPNORM_BETA
    w_branch_attn = jax.random.normal(ks[14], (DEPTH, D_ATTN, D_MODEL), f32) * D_ATTN ** -0.5 * DEEPNORM_BETA
    w_out = jax.random.normal(ks[15], (DEPTH, D_MODEL, D_MODEL), f32) * D_MODEL ** -0.5 * DEEPNORM_BETA
    ln_gain = 1.0 + 0.02 * jax.random.normal(ks[16], (DEPTH, D_MODEL), f32)
    ln_bias = 0.02 * jax.random.normal(ks[17], (DEPTH, D_MODEL), f32)
    return {"x": x, "w_in": w_in, "ssm_lambda_re": ssm_lambda_re, "ssm_lambda_im": ssm_lambda_im,
            "ssm_b_re": ssm_b_re, "ssm_b_im": ssm_b_im, "ssm_c_re": ssm_c_re, "ssm_c_im": ssm_c_im,
            "ssm_d": ssm_d, "ssm_log_step": ssm_log_step, "w_glu": w_glu, "attn_sinks": attn_sinks,
            "rel_bias_table": rel_bias_table, "w_branch_ssm": w_branch_ssm, "w_branch_attn": w_branch_attn,
            "w_out": w_out, "ln_gain": ln_gain, "ln_bias": ln_bias}


def reference(x, w_in, ssm_lambda_re, ssm_lambda_im, ssm_b_re, ssm_b_im, ssm_c_re, ssm_c_im,
              ssm_d, ssm_log_step, w_glu, attn_sinks, rel_bias_table, w_branch_ssm, w_branch_attn,
              w_out, ln_gain, ln_bias):
    for layer in range(DEPTH):
        proj = jnp.einsum("bsd,de->bse", x, w_in[layer])
        u_ssm, z_ssm, q, k, v, z_attn, gate_logits = _split_columns(proj)

        y_ssm = _s5_ssm(u_ssm, ssm_lambda_re[layer], ssm_lambda_im[layer], ssm_b_re[layer], ssm_b_im[layer],
                        ssm_c_re[layer], ssm_c_im[layer], ssm_d[layer], ssm_log_step[layer])
        glu_in = jax.nn.gelu(y_ssm, approximate=False)
        glu_a, glu_b = jnp.split(jnp.einsum("bsc,ce->bse", glu_in, w_glu[layer].astype(jnp.float32)), 2, axis=-1)
        h_ssm = (glu_a * jax.nn.sigmoid(glu_b)).astype(x.dtype) * jax.nn.silu(z_ssm)

        h_attn = _sliding_window_gqa(q, k, v, attn_sinks[layer], rel_bias_table) * jax.nn.silu(z_attn)

        gates = jax.nn.sigmoid(gate_logits.astype(jnp.float32)).astype(x.dtype)
        gate_ssm, gate_attn = jnp.split(gates, 2, axis=-1)
        merged = (gate_ssm * jnp.einsum("bsc,cd->bsd", h_ssm, w_branch_ssm[layer])
                  + gate_attn * jnp.einsum("bsc,cd->bsd", h_attn, w_branch_attn[layer]))
        out = jnp.einsum("bsd,de->bse", merged, w_out[layer])

        x = _layer_norm(DEEPNORM_ALPHA * x + out.astype(x.dtype), ln_gain[layer], ln_bias[layer])
    return x
```

```cpp
#include <hip/hip_runtime.h>
#include <hip/hip_cooperative_groups.h>
#include <cstdio>
#include <cstdint>
namespace cg = cooperative_groups;

#ifndef MK_N_LAUNCHES
#define MK_N_LAUNCHES 8
#endif

constexpr int BATCH = 4, SEQ = 8192, DM = 2048, M = BATCH * SEQ;
constexpr int D_SSM = 1024, NG = 64, GRP = 16, NST = 64;
constexpr int NQH = 16, NKVH = 4, HD = 64, D_ATTN = 1024, D_KV = 256;
constexpr int D_IN = 8704;
constexpr float LN_EPS = 1e-5f;
constexpr float LOG2E = 1.4426950408889634f;
#define DEEPNORM_ALPHA 1.189207115002721f

namespace pg8 {
#define PG8_LAS __attribute__((address_space(3)))
typedef unsigned short bf16_t;
typedef short bf16x8 __attribute__((ext_vector_type(8)));
typedef float f32x4 __attribute__((ext_vector_type(4)));
typedef unsigned u32x4 __attribute__((ext_vector_type(4)));
constexpr int BM = 256, BK = 64, HALF = 128, HTB = HALF * BK * 2, STAGE_BYTES = 8 * HTB, NXCD = 8, WGM = 8;

__host__ __device__ __forceinline__ int lds_byte(int r, int c) { const int st = (r >> 4) * 2 + (c >> 5), rr = r & 15, cc = c & 31, ob = rr * 64 + cc * 2; return st * 1024 + (ob ^ (((ob >> 9) & 1) << 5)); }
__host__ __device__ __forceinline__ void stage_rc(int b, int& R, int& C) { const int st = b / 1024, sb = b % 1024, swz = sb ^ (((sb >> 9) & 1) << 5); R = (st >> 1) * 16 + swz / 64; C = (st & 1) * 32 + (swz % 64) / 2; }
__host__ __device__ __forceinline__ int perm32(int rho) { const int n = rho >> 4, i = rho & 15; return 8 * (i >> 2) + 4 * n + (i & 3); }

struct Unit { int pm, pn; };
struct Gemm { const bf16_t* A; const bf16_t* Bt; int K; int amode; };

struct StaticOrder {
    int nM, nN, nwg, G, c;
    __host__ __device__ void init(int M_, int N_, int G_, int c_) { nM = M_ / BM; nN = N_ / BM; nwg = nM * nN; G = G_; c = c_; }
    __host__ __device__ bool next(int i, Unit& u) const {
        const long L = (long)i * G + c; if (L >= nwg) return false;
        int wgid = (int)L; { const int q = nwg / NXCD, r = nwg % NXCD, xcd = wgid % NXCD, off = wgid / NXCD; wgid = (xcd < r ? xcd * (q + 1) : r * (q + 1) + (xcd - r) * q) + off; }
        const int nig = WGM * nN, gid = wgid / nig, fm = gid * WGM, gsz = (nM - fm) < WGM ? (nM - fm) : WGM;
        u.pm = fm + ((wgid % nig) % gsz); u.pn = (wgid % nig) / gsz; return true;
    }
    __device__ __forceinline__ void a_ready(const Unit&) const {}
    __device__ __forceinline__ void done(const Unit&) const {}
};

typedef float f32x2_t __attribute__((ext_vector_type(2))); typedef __bf16 bf16x2_t __attribute__((ext_vector_type(2)));
__device__ __forceinline__ unsigned cvt_pk_bf16(float lo, float hi) { f32x2_t v = {lo, hi}; bf16x2_t b = __builtin_convertvector(v, bf16x2_t); return __builtin_bit_cast(unsigned, b); }
__device__ __forceinline__ float bf_lo(unsigned w) { return __uint_as_float(w << 16); }
__device__ __forceinline__ float bf_hi(unsigned w) { return __uint_as_float(w & 0xffff0000u); }
__device__ __forceinline__ float sigmoid_f(float x) { return __builtin_amdgcn_rcpf(1.0f + __builtin_amdgcn_exp2f(-x * LOG2E)); }
__device__ __forceinline__ float silu_f(float x) { return x * sigmoid_f(x); }
__device__ __forceinline__ float gelu_f(float v) {
    const float av = __builtin_fabsf(v), d = av * 0.2316418882f + 1.0f, t = __builtin_amdgcn_rcpf(d);
    float q = t * 0.5307027145f + (-0.7265760135f); q = q * t + 0.7107068705f; q = q * t + (-0.142248368f); q = q * t + 0.127414796f; q = q * t;
    const float e = __builtin_amdgcn_exp2f((v * v) * (-0.72134752044f));
    const float m = v * (q * e);
    return v < 0.f ? m : v - m;
}

template <int ACT> __device__ __forceinline__ float act_f(float v) {
    if (ACT == 1) return silu_f(v);
    if (ACT == 2) return v * (0.125f * LOG2E);
    if (ACT == 3) return sigmoid_f(v);
    return v;
}
template <int ACT, bool GM> __device__ __forceinline__ void store_tile_bf16(const f32x4 (&acc)[2][2][4][2], bf16_t* base, int ld, int row0, int col0) {
#pragma unroll
    for (int ai = 0; ai < 2; ++ai)
#pragma unroll
        for (int m = 0; m < 4; ++m) { const int row = row0 + ai * HALF + m * 16;
#pragma unroll
            for (int bj = 0; bj < 2; ++bj) { const int col = col0 + bj * HALF; const f32x4 v0 = acc[ai][bj][m][0], v1 = acc[ai][bj][m][1];
                u32x4 w; w.x = cvt_pk_bf16(act_f<ACT>(v0[0]), act_f<ACT>(v0[1])); w.y = cvt_pk_bf16(act_f<ACT>(v0[2]), act_f<ACT>(v0[3]));
                w.z = cvt_pk_bf16(act_f<ACT>(v1[0]), act_f<ACT>(v1[1])); w.w = cvt_pk_bf16(act_f<ACT>(v1[2]), act_f<ACT>(v1[3]));
                bf16_t* p = GM ? base + ((size_t)((row >> 13) * 64 + (col >> 4)) * 8192 + (row & 8191)) * 16 + (col & 15) : base + (size_t)row * ld + col;
                *(u32x4*)p = w; } }
}
struct EpiInProj {
    static constexpr bool PERM = true, AFTER_DRAIN = false;
    bf16_t *U, *ZS, *Q, *Kb, *Vb, *ZA, *GS, *GA;
    __device__ __forceinline__ void operator()(const f32x4 (&acc)[2][2][4][2], const Unit& u, int wr, int wc, int fr, int fq) const {
        const int pn = u.pn, row0 = u.pm * BM + wr * 64 + fr, cw = wc * 32 + 8 * fq;
        if (pn < 4)        store_tile_bf16<0, true >(acc, U, 0, row0, pn * 256 + cw);
        else if (pn < 8)   store_tile_bf16<1, false>(acc, ZS, 1024, row0, (pn - 4) * 256 + cw);
        else if (pn < 12)  store_tile_bf16<2, false>(acc, Q, 1024, row0, (pn - 8) * 256 + cw);
        else if (pn == 12) store_tile_bf16<0, false>(acc, Kb, 256, row0, cw);
        else if (pn == 13) store_tile_bf16<0, false>(acc, Vb, 256, row0, cw);
        else if (pn < 18)  store_tile_bf16<1, false>(acc, ZA, 1024, row0, (pn - 14) * 256 + cw);
        else if (pn < 26)  store_tile_bf16<3, false>(acc, GS, 2048, row0, (pn - 18) * 256 + cw);
        else               store_tile_bf16<3, false>(acc, GA, 2048, row0, (pn - 26) * 256 + cw);
    }
};
struct EpiGlu {
    static constexpr bool PERM = true, AFTER_DRAIN = false;
    const bf16_t* ZS; bf16_t* HS;
    __device__ __forceinline__ void operator()(const f32x4 (&acc)[2][2][4][2], const Unit& u, int wr, int wc, int fr, int fq) const {
        const int row0 = u.pm * BM + wr * 64 + fr, j0 = u.pn * 128 + wc * 32 + 8 * fq;
#pragma unroll
        for (int ai = 0; ai < 2; ++ai)
#pragma unroll
            for (int m = 0; m < 4; ++m) { const size_t off = (size_t)(row0 + ai * HALF + m * 16) * 1024 + j0;
                const u32x4 z = *(const u32x4*)(ZS + off);
                const f32x4 a0 = acc[ai][0][m][0], a1 = acc[ai][0][m][1], b0 = acc[ai][1][m][0], b1 = acc[ai][1][m][1];
                u32x4 w;
                w.x = cvt_pk_bf16(a0[0] * sigmoid_f(b0[0]) * bf_lo(z.x), a0[1] * sigmoid_f(b0[1]) * bf_hi(z.x));
                w.y = cvt_pk_bf16(a0[2] * sigmoid_f(b0[2]) * bf_lo(z.y), a0[3] * sigmoid_f(b0[3]) * bf_hi(z.y));
                w.z = cvt_pk_bf16(a1[0] * sigmoid_f(b1[0]) * bf_lo(z.z), a1[1] * sigmoid_f(b1[1]) * bf_hi(z.z));
                w.w = cvt_pk_bf16(a1[2] * sigmoid_f(b1[2]) * bf_lo(z.w), a1[3] * sigmoid_f(b1[3]) * bf_hi(z.w));
                *(u32x4*)(HS + off) = w; }
    }
};
template <bool ADD> struct EpiGate {
    static constexpr bool PERM = true, AFTER_DRAIN = false;
    const bf16_t* G; bf16_t* O;
    __device__ __forceinline__ void operator()(const f32x4 (&acc)[2][2][4][2], const Unit& u, int wr, int wc, int fr, int fq) const {
        const int row0 = u.pm * BM + wr * 64 + fr, col0 = u.pn * BM + wc * 32 + 8 * fq;
#pragma unroll
        for (int ai = 0; ai < 2; ++ai)
#pragma unroll
            for (int m = 0; m < 4; ++m)
#pragma unroll
                for (int bj = 0; bj < 2; ++bj) { const size_t off = (size_t)(row0 + ai * HALF + m * 16) * 2048 + col0 + bj * HALF;
                    const u32x4 g = *(const u32x4*)(G + off); const f32x4 v0 = acc[ai][bj][m][0], v1 = acc[ai][bj][m][1];
                    float o[8] = {v0[0] * bf_lo(g.x), v0[1] * bf_hi(g.x), v0[2] * bf_lo(g.y), v0[3] * bf_hi(g.y), v1[0] * bf_lo(g.z), v1[1] * bf_hi(g.z), v1[2] * bf_lo(g.w), v1[3] * bf_hi(g.w)};
                    if (ADD) { const u32x4 p = *(const u32x4*)(O + off);
                        o[0] += bf_lo(p.x); o[1] += bf_hi(p.x); o[2] += bf_lo(p.y); o[3] += bf_hi(p.y); o[4] += bf_lo(p.z); o[5] += bf_hi(p.z); o[6] += bf_lo(p.w); o[7] += bf_hi(p.w); }
                    u32x4 w; w.x = cvt_pk_bf16(o[0], o[1]); w.y = cvt_pk_bf16(o[2], o[3]); w.z = cvt_pk_bf16(o[4], o[5]); w.w = cvt_pk_bf16(o[6], o[7]);
                    *(u32x4*)(O + off) = w; }
    }
};
struct EpiResid {
    static constexpr bool PERM = false, AFTER_DRAIN = false;
    const float* X; float* C;
    __device__ __forceinline__ void operator()(const f32x4 (&acc)[2][2][4][2], const Unit& u, int wr, int wc, int fr, int fq) const {
        const int row0 = u.pm * BM + wr * 64 + fr, col0 = u.pn * BM + wc * 32 + 4 * fq;
#pragma unroll
        for (int ai = 0; ai < 2; ++ai)
#pragma unroll
            for (int m = 0; m < 4; ++m) { const size_t ro = (size_t)(row0 + ai * HALF + m * 16) * DM + col0;
#pragma unroll
                for (int bj = 0; bj < 2; ++bj)
#pragma unroll
                    for (int n = 0; n < 2; ++n) { const f32x4 xv = *(const f32x4*)(X + ro + bj * HALF + n * 16); *(f32x4*)(C + ro + bj * HALF + n * 16) = xv * DEEPNORM_ALPHA + acc[ai][bj][m][n]; } }
    }
};

template <class Epi, class Sched, bool ALIGN_EPI = false, bool SP2 = false>
__device__ __forceinline__ void gemm_phase(PG8_LAS unsigned char* lds, const Gemm g, const Sched& S, const Epi& E) {
    const int tid = threadIdx.x, wid = __builtin_amdgcn_readfirstlane(tid >> 6), lane = tid & 63, wr = wid >> 2, wc = wid & 3, fr = lane & 15, fq = lane >> 4;
    const int K = g.K, nt = K / BK;
    unsigned voffA[2], voffB[2];
#pragma unroll
    for (int i = 0; i < 2; ++i) { int R, C; stage_rc(tid * 16 + i * 8192, R, C); const int Rb = Epi::PERM ? ((R & ~31) + perm32(R & 31)) : R;
        voffA[i] = g.amode ? (unsigned)((((C >> 4) * 8192 + R) * 16 + (C & 15)) * 2) : (unsigned)(R * K + C) * 2u;
        voffB[i] = (unsigned)(Rb * K + C) * 2u; }
    const size_t kstepB = (size_t)(BK * 2), hstepB = (size_t)HALF * K * 2, tstepB = 2 * hstepB;
    const size_t kstepA = g.amode ? (size_t)4 * 8192 * 32 : (size_t)(BK * 2), hstepA = g.amode ? (size_t)HALF * 32 : (size_t)HALF * K * 2;
#define PG8_TILEA(pm) (g.amode ? (const char*)g.A + ((size_t)((pm) >> 5) * 64 * 8192 + (size_t)((pm) & 31) * 256) * 32 : (const char*)g.A + (size_t)(pm) * 2 * hstepA)
    const unsigned ldsw = (unsigned)wid * 1024u;
    const int aoff = lds_byte(wr * 64 + fr, fq * 8), boff = lds_byte(wc * 32 + fr, fq * 8);
#define PG8_SA(b, h) (((b) * 2 + (h)) * HTB)
#define PG8_SB(b, h) ((4 + (b) * 2 + (h)) * HTB)
#define PG8_STAGE(bufoff, gbase, voff) do { _Pragma("unroll") for (int _i = 0; _i < 2; ++_i) \
        __builtin_amdgcn_global_load_lds((const unsigned*)((const char*)(gbase) + (voff)[_i]), (PG8_LAS unsigned*)(lds + (bufoff) + ldsw + _i * 8192), 16, 0, 0); } while (0)
#define PG8_LDA(dst, b, h) do { _Pragma("unroll") for (int m = 0; m < 4; ++m) _Pragma("unroll") for (int k = 0; k < 2; ++k) dst[m][k] = *(const PG8_LAS bf16x8*)(lds + PG8_SA(b, h) + aoff + m * 2048 + k * 1024); } while (0)
#define PG8_LDB(dst, b, h) do { _Pragma("unroll") for (int n = 0; n < 2; ++n) _Pragma("unroll") for (int k = 0; k < 2; ++k) dst[n][k] = *(const PG8_LAS bf16x8*)(lds + PG8_SB(b, h) + boff + n * 2048 + k * 1024); } while (0)
#define PG8_MMA(ai, bj, At, Bt) do { __builtin_amdgcn_s_setprio(1); _Pragma("unroll") for (int m = 0; m < 4; ++m) _Pragma("unroll") for (int n = 0; n < 2; ++n) _Pragma("unroll") for (int k = 0; k < 2; ++k) \
        acc[ai][bj][m][n] = __builtin_amdgcn_mfma_f32_16x16x32_bf16(Bt[n][k], At[m][k], acc[ai][bj][m][n], 0, 0, 0); __builtin_amdgcn_s_setprio(0); } while (0)
#define PG8_WAIT_V(n) asm volatile("s_waitcnt vmcnt(" #n ")" ::: "memory")
#define PG8_WAIT_L(n) asm volatile("s_waitcnt lgkmcnt(" #n ")" ::: "memory")
#define PG8_BAR __builtin_amdgcn_s_barrier()
#define PG8_SCHED __builtin_amdgcn_sched_barrier(0)
    Unit cur, nxt; int ui = 0;
    if (!S.next(0, cur)) return;
    f32x4 acc[2][2][4][2];
#pragma unroll
    for (int a = 0; a < 2; ++a)
#pragma unroll
        for (int b = 0; b < 2; ++b)
#pragma unroll
            for (int m = 0; m < 4; ++m)
#pragma unroll
                for (int n = 0; n < 2; ++n) acc[a][b][m][n] = (f32x4){0.f, 0.f, 0.f, 0.f};
    bf16x8 At[4][2], B0[2][2], B1[2][2];
    const char* cA = PG8_TILEA(cur.pm); const char* cB = (const char*)g.Bt + (size_t)cur.pn * tstepB;
    S.a_ready(cur);
    if constexpr (SP2) {
        PG8_STAGE(PG8_SB(0, 0), cB, voffB); PG8_STAGE(PG8_SB(0, 1), cB + hstepB, voffB); PG8_STAGE(PG8_SA(0, 0), cA, voffA); PG8_STAGE(PG8_SA(0, 1), cA + hstepA, voffA);
        if (wr == 1) PG8_BAR;
        PG8_WAIT_V(2); PG8_BAR;
        PG8_STAGE(PG8_SB(1, 0), cB + kstepB, voffB); PG8_STAGE(PG8_SA(1, 0), cA + kstepA, voffA); PG8_STAGE(PG8_SB(1, 1), cB + hstepB + kstepB, voffB);
        PG8_WAIT_V(6); PG8_BAR;
    } else {
        PG8_STAGE(PG8_SB(0, 0), cB, voffB); PG8_STAGE(PG8_SA(0, 0), cA, voffA); PG8_STAGE(PG8_SB(0, 1), cB + hstepB, voffB); PG8_STAGE(PG8_SA(0, 1), cA + hstepA, voffA);
        if (wr == 1) PG8_BAR;
        PG8_WAIT_V(4); PG8_BAR;
        PG8_STAGE(PG8_SB(1, 0), cB + kstepB, voffB); PG8_STAGE(PG8_SA(1, 0), cA + kstepA, voffA); PG8_STAGE(PG8_SB(1, 1), cB + hstepB + kstepB, voffB);
        PG8_WAIT_V(6); PG8_BAR;
    }
    for (;;) {
        const bool has_next = S.next(ui + 1, nxt);
        const char* nA = has_next ? PG8_TILEA(nxt.pm) : cA; const char* nB = has_next ? (const char*)g.Bt + (size_t)nxt.pn * tstepB : cB;
        for (int t = 0; t < nt; t += 2) {
            const bool last = (t == nt - 2);
            const char* a1 = cA + (size_t)(t + 1) * kstepA;
            const char* a2 = last ? nA : cA + (size_t)(t + 2) * kstepA; const char* b2 = last ? nB : cB + (size_t)(t + 2) * kstepB;
            const char* a3 = a2 + kstepA; const char* b3 = b2 + kstepB;
            if (last && has_next) S.a_ready(nxt);
            if constexpr (SP2) {
            PG8_LDB(B0, 0, 0); PG8_LDB(B1, 0, 1); PG8_SCHED; PG8_LDA(At, 0, 0); PG8_STAGE(PG8_SA(1, 1), a1 + hstepA, voffA);
            PG8_WAIT_V(8); PG8_WAIT_L(0); PG8_BAR; PG8_MMA(0, 0, At, B0); PG8_MMA(0, 1, At, B1); PG8_BAR; PG8_SCHED;
            PG8_LDA(At, 0, 1); PG8_STAGE(PG8_SB(0, 0), b2, voffB); PG8_STAGE(PG8_SB(0, 1), b2 + hstepB, voffB); PG8_STAGE(PG8_SA(0, 0), a2, voffA);
            PG8_WAIT_V(8); PG8_WAIT_L(0); PG8_BAR; PG8_MMA(1, 0, At, B0); PG8_MMA(1, 1, At, B1); PG8_BAR; PG8_SCHED;
            PG8_LDB(B0, 1, 0); PG8_LDB(B1, 1, 1); PG8_SCHED; PG8_LDA(At, 1, 0); PG8_STAGE(PG8_SA(0, 1), a2 + hstepA, voffA);
            PG8_WAIT_V(8); PG8_WAIT_L(0); PG8_BAR; PG8_MMA(0, 0, At, B0); PG8_MMA(0, 1, At, B1); PG8_BAR; PG8_SCHED;
            PG8_LDA(At, 1, 1); PG8_STAGE(PG8_SB(1, 0), b3, voffB); PG8_STAGE(PG8_SB(1, 1), b3 + hstepB, voffB); PG8_STAGE(PG8_SA(1, 0), a3, voffA);
            PG8_WAIT_V(8); PG8_WAIT_L(0); PG8_BAR; PG8_MMA(1, 0, At, B0); PG8_MMA(1, 1, At, B1); PG8_BAR; PG8_SCHED;
            } else {
            PG8_LDB(B0, 0, 0); PG8_SCHED; PG8_LDA(At, 0, 0); PG8_STAGE(PG8_SA(1, 1), a1 + hstepA, voffA);
            PG8_WAIT_L(8); PG8_BAR; PG8_WAIT_L(0); PG8_MMA(0, 0, At, B0); PG8_BAR; PG8_SCHED;
            PG8_LDB(B1, 0, 1); PG8_STAGE(PG8_SB(0, 0), b2, voffB);
            PG8_BAR; PG8_WAIT_L(0); PG8_MMA(0, 1, At, B1); PG8_BAR;
            PG8_LDA(At, 0, 1); PG8_STAGE(PG8_SA(0, 0), a2, voffA);
            PG8_BAR; PG8_WAIT_L(0); PG8_MMA(1, 0, At, B0); PG8_BAR; PG8_SCHED;
            PG8_STAGE(PG8_SB(0, 1), b2 + hstepB, voffB);
            PG8_WAIT_V(6); PG8_BAR; PG8_MMA(1, 1, At, B1); PG8_BAR;
            PG8_LDB(B0, 1, 0); PG8_SCHED; PG8_LDA(At, 1, 0); PG8_STAGE(PG8_SA(0, 1), a2 + hstepA, voffA);
            PG8_WAIT_L(8); PG8_BAR; PG8_WAIT_L(0); PG8_MMA(0, 0, At, B0); PG8_BAR; PG8_SCHED;
            PG8_LDB(B1, 1, 1); PG8_STAGE(PG8_SB(1, 0), b3, voffB);
            PG8_BAR; PG8_WAIT_L(0); PG8_MMA(0, 1, At, B1); PG8_BAR;
            PG8_LDA(At, 1, 1); PG8_STAGE(PG8_SA(1, 0), a3, voffA);
            PG8_BAR; PG8_WAIT_L(0); PG8_MMA(1, 0, At, B0); PG8_BAR; PG8_SCHED;
            PG8_STAGE(PG8_SB(1, 1), b3 + hstepB, voffB);
            PG8_WAIT_V(6); PG8_BAR; PG8_MMA(1, 1, At, B1); PG8_BAR;
            }
        }
        if constexpr (ALIGN_EPI) { if (wr == 0) PG8_BAR; }
        if constexpr (!Epi::AFTER_DRAIN) { E(acc, cur, wr, wc, fr, fq); S.done(cur); }
        if (!has_next) break;
#pragma unroll
        for (int a = 0; a < 2; ++a)
#pragma unroll
            for (int b = 0; b < 2; ++b)
#pragma unroll
                for (int m = 0; m < 4; ++m)
#pragma unroll
                    for (int n = 0; n < 2; ++n) acc[a][b][m][n] = (f32x4){0.f, 0.f, 0.f, 0.f};
        cur = nxt; cA = nA; cB = nB; ++ui;
        if constexpr (ALIGN_EPI) { if (wr == 1) PG8_BAR; }
    }
    PG8_WAIT_V(0);
    if constexpr (!ALIGN_EPI) { if (wr == 0) PG8_BAR; }
    PG8_BAR;
#undef PG8_TILEA
#undef PG8_SA
#undef PG8_SB
#undef PG8_STAGE
#undef PG8_LDA
#undef PG8_LDB
#undef PG8_MMA
#undef PG8_WAIT_V
#undef PG8_WAIT_L
#undef PG8_BAR
#undef PG8_SCHED
}
}

constexpr int NWAVES = 8;
constexpr int N_PHASES = 8;
constexpr size_t MiB = 1u << 20;
constexpr size_t WS_CTL = 0;
constexpr size_t WS_BIAS = 64 * 1024;
constexpr size_t WS_WIN = 1 * MiB;
constexpr size_t WS_WGLU = 36 * MiB;
constexpr size_t WS_WBS = 40 * MiB, WS_WBA = 44 * MiB;
constexpr size_t WS_WOUT = 48 * MiB;
constexpr size_t WS_XB = 64 * MiB;
constexpr size_t WS_U = 192 * MiB;
constexpr size_t WS_ZS = 256 * MiB;
constexpr size_t WS_Q = 320 * MiB;
constexpr size_t WS_K = 384 * MiB, WS_V = 400 * MiB;
constexpr size_t WS_ZA = 416 * MiB;
constexpr size_t WS_GS = 480 * MiB, WS_GA = 608 * MiB;
constexpr size_t WS_Y = 736 * MiB;
constexpr size_t WS_HA = 800 * MiB;
constexpr size_t WS_END = 864 * MiB;

constexpr int RING_BYTES = 131072, LDS_BYTES = 147456;

#define GAS __attribute__((address_space(1)))
#define LAS __attribute__((address_space(3)))
typedef unsigned short bf16;
typedef unsigned v4u __attribute__((ext_vector_type(4)));
typedef float f32x4 __attribute__((ext_vector_type(4)));
#define LDS_WAIT() asm volatile("s_waitcnt lgkmcnt(0)" ::: "memory")
__device__ __forceinline__ unsigned f2bf(float f) { unsigned u = __builtin_bit_cast(unsigned, f); return (u + 0x7fffu + ((u >> 16) & 1u)) >> 16; }
__device__ __forceinline__ unsigned pk2(float lo, float hi) { return f2bf(lo) | (f2bf(hi) << 16); }
__device__ __forceinline__ float bf2f(unsigned short h) { return __uint_as_float(((unsigned)h) << 16); }

__device__ __forceinline__ void p0_transpose_item(const float* W, int K, int N, bf16* WT, int k0, int n0, int wt_row0, LAS float* scr, int lane) {
#pragma unroll 8
    for (int i = 0; i < 32; ++i) { const int kk = 2 * i + (lane >> 5); scr[kk * 33 + (lane & 31)] = W[(size_t)(k0 + kk) * N + n0 + (lane & 31)]; }
    LDS_WAIT(); asm volatile("" ::: "memory");
    const int c = lane & 7;
#pragma unroll
    for (int j = 0; j < 4; ++j) { const int n = (lane >> 3) + 8 * j; const LAS float* s = scr + (8 * c) * 33 + n;
        v4u o; o.x = pk2(s[0 * 33], s[1 * 33]); o.y = pk2(s[2 * 33], s[3 * 33]); o.z = pk2(s[4 * 33], s[5 * 33]); o.w = pk2(s[6 * 33], s[7 * 33]);
        *(GAS v4u*)(WT + (size_t)(wt_row0 + n) * K + k0 + 8 * c) = o; }
    LDS_WAIT(); asm volatile("" ::: "memory");
}

__device__ __forceinline__ int t5_bucket(int dist) {
    if (dist < 16) return dist;
    const float d = (float)dist;
    int large = 16 + (int)(logf(d / 16.0f) / logf(8.0f) * 16.0f);
    return large < 31 ? large : 31;
}

struct Args { const float* in[18]; float* out; unsigned char* ws; int ph_lo, ph_hi; };

__device__ __forceinline__ void ssm_simple_unit(const Args& a, int unit, int lane) {
    const int b = unit >> 6, g = unit & 63, p = lane;
    const float* lam_re = a.in[2]; const float* lam_im = a.in[3]; const float* b_re = a.in[4]; const float* b_im = a.in[5];
    const float* c_re = a.in[6]; const float* c_im = a.in[7]; const float* dsk = a.in[8]; const float* lstep = a.in[9];
    const float step = expf(lstep[g]);
    const float lr = lam_re[g * 64 + p], li = lam_im[g * 64 + p];
    const float mag = expf(lr * step); float sn, cs; sincosf(li * step, &sn, &cs);
    const float ar = mag * cs, ai = mag * sn;
    const float nr = ar - 1.0f, ni = ai, den = lr * lr + li * li;
    const float fr = (nr * lr + ni * li) / den, fi = (ni * lr - nr * li) / den;
    float bbr[16], bbi[16], cr[16], ci[16], dd[16];
#pragma unroll
    for (int h = 0; h < 16; ++h) { const float br = b_re[(g * 64 + p) * 16 + h], bi = b_im[(g * 64 + p) * 16 + h];
        bbr[h] = fr * br - fi * bi; bbi[h] = fr * bi + fi * br;
        cr[h] = c_re[(g * 16 + h) * 64 + p]; ci[h] = c_im[(g * 16 + h) * 64 + p]; dd[h] = dsk[g * 16 + h]; }
    const bf16* U = (const bf16*)(a.ws + WS_U) + (size_t)(b * 64 + g) * 8192 * 16;
    bf16* Y = (bf16*)(a.ws + WS_Y) + (size_t)(b * 64 + g) * 8192 * 16;
    const int hown = 8 * (lane & 1) + 4 * ((lane >> 1) & 1) + 2 * ((lane >> 2) & 1) + ((lane >> 3) & 1);
    float sr = 0.f, si = 0.f;
    for (int t = 0; t < 8192; ++t) {
        const v4u u0 = *(const v4u*)(U + (size_t)t * 16), u1 = *(const v4u*)(U + (size_t)t * 16 + 8);
        float u[16] = {pg8::bf_lo(u0.x), pg8::bf_hi(u0.x), pg8::bf_lo(u0.y), pg8::bf_hi(u0.y), pg8::bf_lo(u0.z), pg8::bf_hi(u0.z), pg8::bf_lo(u0.w), pg8::bf_hi(u0.w),
                       pg8::bf_lo(u1.x), pg8::bf_hi(u1.x), pg8::bf_lo(u1.y), pg8::bf_hi(u1.y), pg8::bf_lo(u1.z), pg8::bf_hi(u1.z), pg8::bf_lo(u1.w), pg8::bf_hi(u1.w)};
        float bur = 0.f, bui = 0.f;
#pragma unroll
        for (int h = 0; h < 16; ++h) { bur += bbr[h] * u[h]; bui += bbi[h] * u[h]; }
        const float nsr = ar * sr - ai * si + bur, nsi = ar * si + ai * sr + bui; sr = nsr; si = nsi;
        float z[16];
#pragma unroll
        for (int h = 0; h < 16; ++h) z[h] = cr[h] * sr - ci[h] * si;
#pragma unroll
        for (int i = 0; i < 8; ++i) { const bool up = (lane & 1) != 0; const float send = up ? z[i] : z[i + 8], keep = up ? z[i + 8] : z[i]; z[i] = keep + __shfl_xor(send, 1); }
#pragma unroll
        for (int i = 0; i < 4; ++i) { const bool up = (lane & 2) != 0; const float send = up ? z[i] : z[i + 4], keep = up ? z[i + 4] : z[i]; z[i] = keep + __shfl_xor(send, 2); }
#pragma unroll
        for (int i = 0; i < 2; ++i) { const bool up = (lane & 4) != 0; const float send = up ? z[i] : z[i + 2], keep = up ? z[i + 2] : z[i]; z[i] = keep + __shfl_xor(send, 4); }
        { const bool up = (lane & 8) != 0; const float send = up ? z[0] : z[1], keep = up ? z[1] : z[0]; z[0] = keep + __shfl_xor(send, 8); }
        float tot = z[0]; tot += __shfl_xor(tot, 16); tot += __shfl_xor(tot, 32);
        float uo = 0.f, dv = 0.f;
#pragma unroll
        for (int h = 0; h < 16; ++h) { if (h == hown) { uo = u[h]; dv = dd[h]; } }
        const float y = tot + dv * uo;
        if (lane < 16) Y[(size_t)t * 16 + hown] = (bf16)f2bf(pg8::gelu_f(y));
    }
}

__device__ __forceinline__ void attn_simple_item(const Args& a, int item) {
    const int row = item >> 4, h = item & 15, kvh = h >> 2, t = row & 8191;
    const bf16* Q = (const bf16*)(a.ws + WS_Q); const bf16* Kb = (const bf16*)(a.ws + WS_K); const bf16* Vb = (const bf16*)(a.ws + WS_V);
    const bf16* ZA = (const bf16*)(a.ws + WS_ZA); bf16* HA = (bf16*)(a.ws + WS_HA);
    const float* biasd = (const float*)(a.ws + WS_BIAS) + h * 128;
    float q[64], o[64];
#pragma unroll
    for (int c = 0; c < 8; ++c) { const v4u w = *(const v4u*)(Q + (size_t)row * 1024 + h * 64 + c * 8);
        q[c * 8 + 0] = pg8::bf_lo(w.x); q[c * 8 + 1] = pg8::bf_hi(w.x); q[c * 8 + 2] = pg8::bf_lo(w.y); q[c * 8 + 3] = pg8::bf_hi(w.y);
        q[c * 8 + 4] = pg8::bf_lo(w.z); q[c * 8 + 5] = pg8::bf_hi(w.z); q[c * 8 + 6] = pg8::bf_lo(w.w); q[c * 8 + 7] = pg8::bf_hi(w.w); }
#pragma unroll
    for (int d = 0; d < 64; ++d) o[d] = 0.f;
    float mx = a.in[11][h] * LOG2E, l = 1.0f;
    const int nd = t < 127 ? t : 127;
    for (int dist = 0; dist <= nd; ++dist) {
        const size_t kr = (size_t)(row - dist) * 256 + kvh * 64;
        float s = 0.f;
#pragma unroll
        for (int c = 0; c < 8; ++c) { const v4u w = *(const v4u*)(Kb + kr + c * 8);
            s += q[c * 8 + 0] * pg8::bf_lo(w.x) + q[c * 8 + 1] * pg8::bf_hi(w.x) + q[c * 8 + 2] * pg8::bf_lo(w.y) + q[c * 8 + 3] * pg8::bf_hi(w.y)
               + q[c * 8 + 4] * pg8::bf_lo(w.z) + q[c * 8 + 5] * pg8::bf_hi(w.z) + q[c * 8 + 6] * pg8::bf_lo(w.w) + q[c * 8 + 7] * pg8::bf_hi(w.w); }
        s += biasd[dist];
        const float mn = fmaxf(mx, s), sc = exp2f(mx - mn), pr = exp2f(s - mn);
        l = l * sc + pr; mx = mn;
#pragma unroll
        for (int c = 0; c < 8; ++c) { const v4u w = *(const v4u*)(Vb + kr + c * 8);
            o[c * 8 + 0] = o[c * 8 + 0] * sc + pr * pg8::bf_lo(w.x); o[c * 8 + 1] = o[c * 8 + 1] * sc + pr * pg8::bf_hi(w.x);
            o[c * 8 + 2] = o[c * 8 + 2] * sc + pr * pg8::bf_lo(w.y); o[c * 8 + 3] = o[c * 8 + 3] * sc + pr * pg8::bf_hi(w.y);
            o[c * 8 + 4] = o[c * 8 + 4] * sc + pr * pg8::bf_lo(w.z); o[c * 8 + 5] = o[c * 8 + 5] * sc + pr * pg8::bf_hi(w.z);
            o[c * 8 + 6] = o[c * 8 + 6] * sc + pr * pg8::bf_lo(w.w); o[c * 8 + 7] = o[c * 8 + 7] * sc + pr * pg8::bf_hi(w.w); }
    }
    const float rl = 1.0f / l;
#pragma unroll
    for (int c = 0; c < 8; ++c) { const size_t off = (size_t)row * 1024 + h * 64 + c * 8; const v4u z = *(const v4u*)(ZA + off);
        v4u w; w.x = pk2(o[c * 8 + 0] * rl * pg8::bf_lo(z.x), o[c * 8 + 1] * rl * pg8::bf_hi(z.x)); w.y = pk2(o[c * 8 + 2] * rl * pg8::bf_lo(z.y), o[c * 8 + 3] * rl * pg8::bf_hi(z.y));
        w.z = pk2(o[c * 8 + 4] * rl * pg8::bf_lo(z.z), o[c * 8 + 5] * rl * pg8::bf_hi(z.z)); w.w = pk2(o[c * 8 + 6] * rl * pg8::bf_lo(z.w), o[c * 8 + 7] * rl * pg8::bf_hi(z.w));
        *(v4u*)(HA + off) = w; }
}

__device__ __forceinline__ float wave_sum(float v) {
#pragma unroll
    for (int o = 1; o < 64; o <<= 1) v += __shfl_xor(v, o);
    return v;
}

__global__ void __launch_bounds__(NWAVES * 64, 2) fwd_megakernel(Args args) {
    extern __shared__ __attribute__((aligned(16))) unsigned char lds[];
    cg::grid_group grid = cg::this_grid();
    const int tid = threadIdx.x, lane = tid & 63, wave = __builtin_amdgcn_readfirstlane(tid >> 6);
    const int G = gridDim.x, bx = blockIdx.x;
    const int vcu = (G % 8 == 0) ? (bx % 8) * (G / 8) + bx / 8 : bx;
    unsigned char* ws = args.ws;
    const int lo = args.ph_lo, hi = args.ph_hi;
#define IN(k) (lo <= (k) && (k) < hi)
#define SEAM(k) do { if (IN(k) && IN((k) + 1)) grid.sync(); } while (0)
    LAS unsigned char* ldsl = (LAS unsigned char*)lds;
    const int gw = vcu * NWAVES + wave, NGW = G * NWAVES;
    const int gt = vcu * (NWAVES * 64) + tid, NGT = G * NWAVES * 64;

    if (IN(0)) {
        { const float* x = args.in[0]; bf16* xb = (bf16*)(ws + WS_XB);
          for (size_t i = (size_t)gt; i < (size_t)M * DM / 8; i += NGT) { const f32x4 a = *(const f32x4*)(x + i * 8), b = *(const f32x4*)(x + i * 8 + 4);
              v4u o; o.x = pk2(a[0], a[1]); o.y = pk2(a[2], a[3]); o.z = pk2(b[0], b[1]); o.w = pk2(b[2], b[3]); *(v4u*)(xb + i * 8) = o; } }
        { LAS float* scr = (LAS float*)(ldsl + wave * 16384);
          constexpr int I_IN = (DM / 64) * (D_IN / 32), I_GLU = (D_SSM / 64) * (2048 / 32), I_BS = I_GLU, I_BA = I_GLU, I_OUT = (DM / 64) * (DM / 32);
          constexpr int NITEMS = I_IN + I_GLU + I_BS + I_BA + I_OUT;
          for (int it = gw; it < NITEMS; it += NGW) {
              int r = it;
              if (r < I_IN) { const int nblk = D_IN / 32, kb = r / nblk, nb = r % nblk; p0_transpose_item(args.in[1], DM, D_IN, (bf16*)(ws + WS_WIN), 64 * kb, 32 * nb, 32 * nb, scr, lane); continue; } r -= I_IN;
              if (r < I_GLU) { const int nblk = 2048 / 32, kb = r / nblk, nb = r % nblk, n0 = 32 * nb;
                  const int wrow = 256 * ((n0 & 1023) >> 7) + 128 * (n0 >> 10) + (n0 & 127);
                  p0_transpose_item(args.in[10], D_SSM, 2048, (bf16*)(ws + WS_WGLU), 64 * kb, n0, wrow, scr, lane); continue; } r -= I_GLU;
              if (r < I_BS) { const int nblk = 2048 / 32, kb = r / nblk, nb = r % nblk; p0_transpose_item(args.in[13], D_SSM, DM, (bf16*)(ws + WS_WBS), 64 * kb, 32 * nb, 32 * nb, scr, lane); continue; } r -= I_BS;
              if (r < I_BA) { const int nblk = 2048 / 32, kb = r / nblk, nb = r % nblk; p0_transpose_item(args.in[14], D_ATTN, DM, (bf16*)(ws + WS_WBA), 64 * kb, 32 * nb, 32 * nb, scr, lane); continue; } r -= I_BA;
              { const int nblk = DM / 32, kb = r / nblk, nb = r % nblk; p0_transpose_item(args.in[15], DM, DM, (bf16*)(ws + WS_WOUT), 64 * kb, 32 * nb, 32 * nb, scr, lane); }
          } }
        if (gt < 16 * 128) { const int h = gt >> 7, dist = gt & 127; ((float*)(ws + WS_BIAS))[gt] = args.in[12][t5_bucket(dist) * 16 + h] * LOG2E; }
        __syncthreads();
    }
    SEAM(0);

    if (IN(1)) {
        pg8::Gemm g{(const bf16*)(ws + WS_XB), (const bf16*)(ws + WS_WIN), DM, 0}; pg8::StaticOrder S; S.init(M, D_IN, G, bx);
        pg8::EpiInProj E{(bf16*)(ws + WS_U), (bf16*)(ws + WS_ZS), (bf16*)(ws + WS_Q), (bf16*)(ws + WS_K), (bf16*)(ws + WS_V), (bf16*)(ws + WS_ZA), (bf16*)(ws + WS_GS), (bf16*)(ws + WS_GA)};
        pg8::gemm_phase<pg8::EpiInProj, pg8::StaticOrder, true, true>(ldsl, g, S, E);
    }
    SEAM(1);

    if (IN(2)) {
        if (wave == 0) { for (int unit = vcu; unit < BATCH * NG; unit += G) ssm_simple_unit(args, unit, lane); }
        else { const int at = vcu * 448 + (tid - 64), NAT = G * 448; for (int item = at; item < M * NQH; item += NAT) attn_simple_item(args, item); }
        __syncthreads();
    }
    SEAM(2);

    if (IN(3)) {
        pg8::Gemm g{(const bf16*)(ws + WS_Y), (const bf16*)(ws + WS_WGLU), D_SSM, 1}; pg8::StaticOrder S; S.init(M, 2048, G, bx);
        pg8::EpiGlu E{(const bf16*)(ws + WS_ZS), (bf16*)(ws + WS_Q)};
        pg8::gemm_phase<pg8::EpiGlu, pg8::StaticOrder, true, true>(ldsl, g, S, E);
    }
    SEAM(3);

    if (IN(4)) {
        pg8::Gemm g{(const bf16*)(ws + WS_Q), (const bf16*)(ws + WS_WBS), D_SSM, 0}; pg8::StaticOrder S; S.init(M, DM, G, bx);
        pg8::EpiGate<false> E{(const bf16*)(ws + WS_GS), (bf16*)(ws + WS_XB)};
        pg8::gemm_phase<pg8::EpiGate<false>, pg8::StaticOrder, true, true>(ldsl, g, S, E);
    }
    SEAM(4);

    if (IN(5)) {
        pg8::Gemm g{(const bf16*)(ws + WS_HA), (const bf16*)(ws + WS_WBA), D_ATTN, 0}; pg8::StaticOrder S; S.init(M, DM, G, bx);
        pg8::EpiGate<true> E{(const bf16*)(ws + WS_GA), (bf16*)(ws + WS_XB)};
        pg8::gemm_phase<pg8::EpiGate<true>, pg8::StaticOrder, true, true>(ldsl, g, S, E);
    }
    SEAM(5);

    if (IN(6)) {
        pg8::Gemm g{(const bf16*)(ws + WS_XB), (const bf16*)(ws + WS_WOUT), DM, 0}; pg8::StaticOrder S; S.init(M, DM, G, bx);
        pg8::EpiResid E{args.in[0], args.out};
        pg8::gemm_phase<pg8::EpiResid, pg8::StaticOrder, true, true>(ldsl, g, S, E);
    }
    SEAM(6);

    if (IN(7)) {
        const float* gain = args.in[16]; const float* bias = args.in[17];
        for (int m = gw; m < M; m += NGW) {
            GAS f32x4* xr = (GAS f32x4*)(args.out + (size_t)m * DM) + lane;
            f32x4 v[8]; float s = 0.f;
#pragma unroll
            for (int j = 0; j < 8; ++j) { v[j] = xr[64 * j]; s += (v[j].x + v[j].y) + (v[j].z + v[j].w); }
            const float mean = wave_sum(s) * (1.f / DM); float s2 = 0.f;
#pragma unroll
            for (int j = 0; j < 8; ++j) { v[j] = v[j] - mean; s2 += (v[j].x * v[j].x + v[j].y * v[j].y) + (v[j].z * v[j].z + v[j].w * v[j].w); }
            const float rstd = 1.f / sqrtf(wave_sum(s2) * (1.f / DM) + LN_EPS);
#pragma unroll
            for (int j = 0; j < 8; ++j) { const f32x4 gn = *(const f32x4*)(gain + (64 * j + lane) * 4), bs = *(const f32x4*)(bias + (64 * j + lane) * 4); xr[64 * j] = v[j] * rstd * gn + bs; }
        }
    }
#undef IN
#undef SEAM
}

extern "C" void kernel_launch(void* const* d_in, const int* in_sizes, int n_in, void* d_out, int out_size, void* d_ws, size_t ws_size, hipStream_t stream) {
    static int grid = 0;
    if (grid == 0) {
        if (n_in != 18 || in_sizes[0] != M * DM || out_size != M * DM || ws_size < WS_END) { fprintf(stderr, "kernel_launch: unexpected shapes (n_in %d, in0 %d, out %d, ws %zu); nothing launched\n", n_in, n_in > 0 ? in_sizes[0] : -1, out_size, ws_size); grid = -1; return; }
        int dev = 0, cus = 0, per_cu = 0;
        if (hipGetDevice(&dev) != hipSuccess || hipDeviceGetAttribute(&cus, hipDeviceAttributeMultiprocessorCount, dev) != hipSuccess) { grid = -1; return; }
        if (hipFuncSetAttribute((const void*)fwd_megakernel, hipFuncAttributeMaxDynamicSharedMemorySize, LDS_BYTES) != hipSuccess) { fprintf(stderr, "kernel_launch: hipFuncSetAttribute failed\n"); grid = -1; return; }
        if (hipOccupancyMaxActiveBlocksPerMultiprocessor(&per_cu, (const void*)fwd_megakernel, NWAVES * 64, LDS_BYTES) != hipSuccess || per_cu < 1) { fprintf(stderr, "kernel_launch: occupancy query says %d\n", per_cu); per_cu = 1; }
        (void)hipGetLastError();
        grid = cus * 1;
    }
    if (grid < 0) return;
    Args a{};
    for (int i = 0; i < 18; ++i) a.in[i] = (const float*)d_in[i];
    a.out = (float*)d_out; a.ws = (unsigned char*)d_ws;
#if MK_N_LAUNCHES == 1
    a.ph_lo = 0; a.ph_hi = N_PHASES;
    void* kargs[] = {&a};
    hipError_t e = hipLaunchCooperativeKernel((const void*)fwd_megakernel, dim3(grid), dim3(NWAVES * 64), kargs, LDS_BYTES, stream);
    if (e != hipSuccess) fprintf(stderr, "cooperative launch failed: %s (grid %d)\n", hipGetErrorString(e), grid);
#else
    for (int p = 0; p < N_PHASES; ++p) { a.ph_lo = p; a.ph_hi = p + 1; hipLaunchKernelGGL(fwd_megakernel, dim3(grid), dim3(NWAVES * 64), LDS_BYTES, stream, a); }
#endif
}
```

```cpp
#include <hip/hip_runtime.h>
#include <hip/hip_cooperative_groups.h>
#include <cstdio>
#include <cstdint>
namespace cg = cooperative_groups;

#ifndef MK_N_LAUNCHES
#define MK_N_LAUNCHES 1
#endif

constexpr int BATCH = 4, SEQ = 8192, DM = 2048, M = BATCH * SEQ;
constexpr int D_SSM = 1024, NG = 64, GRP = 16, NST = 64;
constexpr int NQH = 16, NKVH = 4, HD = 64, D_ATTN = 1024, D_KV = 256;
constexpr int D_IN = 8704;
constexpr float LN_EPS = 1e-5f;
constexpr float LOG2E = 1.4426950408889634f;
#define DEEPNORM_ALPHA 1.189207115002721f

namespace pg8 {
#define PG8_LAS __attribute__((address_space(3)))
typedef unsigned short bf16_t;
typedef short bf16x8 __attribute__((ext_vector_type(8)));
typedef float f32x4 __attribute__((ext_vector_type(4)));
typedef unsigned u32x4 __attribute__((ext_vector_type(4)));
constexpr int BM = 256, BK = 64, HALF = 128, HTB = HALF * BK * 2, STAGE_BYTES = 8 * HTB, NXCD = 8, WGM = 8;

__host__ __device__ __forceinline__ int lds_byte(int r, int c) { const int st = (r >> 4) * 2 + (c >> 5), rr = r & 15, cc = c & 31, ob = rr * 64 + cc * 2; return st * 1024 + (ob ^ (((ob >> 9) & 1) << 5)); }
__host__ __device__ __forceinline__ void stage_rc(int b, int& R, int& C) { const int st = b / 1024, sb = b % 1024, swz = sb ^ (((sb >> 9) & 1) << 5); R = (st >> 1) * 16 + swz / 64; C = (st & 1) * 32 + (swz % 64) / 2; }
__host__ __device__ __forceinline__ int perm32(int rho) { const int n = rho >> 4, i = rho & 15; return 8 * (i >> 2) + 4 * n + (i & 3); }

struct Unit { int pm, pn; };
struct Gemm { const bf16_t* A; const bf16_t* Bt; int K; int amode; };

struct StaticOrder {
    int nM, nN, nwg, G, c;
    __host__ __device__ void init(int M_, int N_, int G_, int c_) { nM = M_ / BM; nN = N_ / BM; nwg = nM * nN; G = G_; c = c_; }
    __host__ __device__ bool next(int i, Unit& u) const {
        const long L = (long)i * G + c; if (L >= nwg) return false;
        int wgid = (int)L; { const int q = nwg / NXCD, r = nwg % NXCD, xcd = wgid % NXCD, off = wgid / NXCD; wgid = (xcd < r ? xcd * (q + 1) : r * (q + 1) + (xcd - r) * q) + off; }
        const int nig = WGM * nN, gid = wgid / nig, fm = gid * WGM, gsz = (nM - fm) < WGM ? (nM - fm) : WGM;
        u.pm = fm + ((wgid % nig) % gsz); u.pn = (wgid % nig) / gsz; return true;
    }
    __device__ __forceinline__ void a_ready(const Unit&) const {}
    __device__ __forceinline__ void done(const Unit&) const {}
};

typedef float f32x2_t __attribute__((ext_vector_type(2))); typedef __bf16 bf16x2_t __attribute__((ext_vector_type(2)));
__device__ __forceinline__ unsigned cvt_pk_bf16(float lo, float hi) { f32x2_t v = {lo, hi}; bf16x2_t b = __builtin_convertvector(v, bf16x2_t); return __builtin_bit_cast(unsigned, b); }
__device__ __forceinline__ float bf_lo(unsigned w) { return __uint_as_float(w << 16); }
__device__ __forceinline__ float bf_hi(unsigned w) { return __uint_as_float(w & 0xffff0000u); }
__device__ __forceinline__ float sigmoid_f(float x) { return __builtin_amdgcn_rcpf(1.0f + __builtin_amdgcn_exp2f(-x * LOG2E)); }
__device__ __forceinline__ float silu_f(float x) { return x * sigmoid_f(x); }
__device__ __forceinline__ float gelu_f(float v) {
    const float av = __builtin_fabsf(v), d = av * 0.2316418882f + 1.0f, t = __builtin_amdgcn_rcpf(d);
    float q = t * 0.5307027145f + (-0.7265760135f); q = q * t + 0.7107068705f; q = q * t + (-0.142248368f); q = q * t + 0.127414796f; q = q * t;
    const float e = __builtin_amdgcn_exp2f((v * v) * (-0.72134752044f));
    const float m = v * (q * e);
    return v < 0.f ? m : v - m;
}

template <int ACT> __device__ __forceinline__ float act_f(float v) {
    if (ACT == 1) return silu_f(v);
    if (ACT == 2) return v * (0.125f * LOG2E);
    if (ACT == 3) return sigmoid_f(v);
    return v;
}
template <int ACT, bool GM> __device__ __forceinline__ void store_tile_bf16(const f32x4 (&acc)[2][2][4][2], bf16_t* base, int ld, int row0, int col0) {
#pragma unroll
    for (int ai = 0; ai < 2; ++ai)
#pragma unroll
        for (int m = 0; m < 4; ++m) { const int row = row0 + ai * HALF + m * 16;
#pragma unroll
            for (int bj = 0; bj < 2; ++bj) { const int col = col0 + bj * HALF; const f32x4 v0 = acc[ai][bj][m][0], v1 = acc[ai][bj][m][1];
                u32x4 w; w.x = cvt_pk_bf16(act_f<ACT>(v0[0]), act_f<ACT>(v0[1])); w.y = cvt_pk_bf16(act_f<ACT>(v0[2]), act_f<ACT>(v0[3]));
                w.z = cvt_pk_bf16(act_f<ACT>(v1[0]), act_f<ACT>(v1[1])); w.w = cvt_pk_bf16(act_f<ACT>(v1[2]), act_f<ACT>(v1[3]));
                bf16_t* p = GM ? base + ((size_t)((row >> 13) * 64 + (col >> 4)) * 8192 + (row & 8191)) * 16 + (col & 15) : base + (size_t)row * ld + col;
                *(u32x4*)p = w; } }
}
struct EpiInProj {
    static constexpr bool PERM = true, AFTER_DRAIN = false;
    bf16_t *U, *ZS, *Q, *Kb, *Vb, *ZA, *GS, *GA;
    __device__ __forceinline__ void operator()(const f32x4 (&acc)[2][2][4][2], const Unit& u, int wr, int wc, int fr, int fq) const {
        const int pn = u.pn, row0 = u.pm * BM + wr * 64 + fr, cw = wc * 32 + 8 * fq;
        if (pn < 4)        store_tile_bf16<0, true >(acc, U, 0, row0, pn * 256 + cw);
        else if (pn < 8)   store_tile_bf16<1, false>(acc, ZS, 1024, row0, (pn - 4) * 256 + cw);
        else if (pn < 12)  store_tile_bf16<2, false>(acc, Q, 1024, row0, (pn - 8) * 256 + cw);
        else if (pn == 12) store_tile_bf16<0, false>(acc, Kb, 256, row0, cw);
        else if (pn == 13) store_tile_bf16<0, false>(acc, Vb, 256, row0, cw);
        else if (pn < 18)  store_tile_bf16<1, false>(acc, ZA, 1024, row0, (pn - 14) * 256 + cw);
        else if (pn < 26)  store_tile_bf16<3, false>(acc, GS, 2048, row0, (pn - 18) * 256 + cw);
        else               store_tile_bf16<3, false>(acc, GA, 2048, row0, (pn - 26) * 256 + cw);
    }
};
struct EpiGlu {
    static constexpr bool PERM = true, AFTER_DRAIN = false;
    const bf16_t* ZS; bf16_t* HS;
    __device__ __forceinline__ void operator()(const f32x4 (&acc)[2][2][4][2], const Unit& u, int wr, int wc, int fr, int fq) const {
        const int row0 = u.pm * BM + wr * 64 + fr, j0 = u.pn * 128 + wc * 32 + 8 * fq;
#pragma unroll
        for (int ai = 0; ai < 2; ++ai)
#pragma unroll
            for (int m = 0; m < 4; ++m) { const size_t off = (size_t)(row0 + ai * HALF + m * 16) * 1024 + j0;
                const u32x4 z = *(const u32x4*)(ZS + off);
                const f32x4 a0 = acc[ai][0][m][0], a1 = acc[ai][0][m][1], b0 = acc[ai][1][m][0], b1 = acc[ai][1][m][1];
                u32x4 w;
                w.x = cvt_pk_bf16(a0[0] * sigmoid_f(b0[0]) * bf_lo(z.x), a0[1] * sigmoid_f(b0[1]) * bf_hi(z.x));
                w.y = cvt_pk_bf16(a0[2] * sigmoid_f(b0[2]) * bf_lo(z.y), a0[3] * sigmoid_f(b0[3]) * bf_hi(z.y));
                w.z = cvt_pk_bf16(a1[0] * sigmoid_f(b1[0]) * bf_lo(z.z), a1[1] * sigmoid_f(b1[1]) * bf_hi(z.z));
                w.w = cvt_pk_bf16(a1[2] * sigmoid_f(b1[2]) * bf_lo(z.w), a1[3] * sigmoid_f(b1[3]) * bf_hi(z.w));
                *(u32x4*)(HS + off) = w; }
    }
};
template <bool ADD> struct EpiGate {
    static constexpr bool PERM = true, AFTER_DRAIN = false;
    const bf16_t* G; bf16_t* O;
    __device__ __forceinline__ void operator()(const f32x4 (&acc)[2][2][4][2], const Unit& u, int wr, int wc, int fr, int fq) const {
        const int row0 = u.pm * BM + wr * 64 + fr, col0 = u.pn * BM + wc * 32 + 8 * fq;
#pragma unroll
        for (int ai = 0; ai < 2; ++ai)
#pragma unroll
            for (int m = 0; m < 4; ++m)
#pragma unroll
                for (int bj = 0; bj < 2; ++bj) { const size_t off = (size_t)(row0 + ai * HALF + m * 16) * 2048 + col0 + bj * HALF;
                    const u32x4 g = *(const u32x4*)(G + off); const f32x4 v0 = acc[ai][bj][m][0], v1 = acc[ai][bj][m][1];
                    float o[8] = {v0[0] * bf_lo(g.x), v0[1] * bf_hi(g.x), v0[2] * bf_lo(g.y), v0[3] * bf_hi(g.y), v1[0] * bf_lo(g.z), v1[1] * bf_hi(g.z), v1[2] * bf_lo(g.w), v1[3] * bf_hi(g.w)};
                    if (ADD) { const u32x4 p = *(const u32x4*)(O + off);
                        o[0] += bf_lo(p.x); o[1] += bf_hi(p.x); o[2] += bf_lo(p.y); o[3] += bf_hi(p.y); o[4] += bf_lo(p.z); o[5] += bf_hi(p.z); o[6] += bf_lo(p.w); o[7] += bf_hi(p.w); }
                    u32x4 w; w.x = cvt_pk_bf16(o[0], o[1]); w.y = cvt_pk_bf16(o[2], o[3]); w.z = cvt_pk_bf16(o[4], o[5]); w.w = cvt_pk_bf16(o[6], o[7]);
                    *(u32x4*)(O + off) = w; }
    }
};
struct EpiResid {
    static constexpr bool PERM = false, AFTER_DRAIN = false;
    const float* X; float* C;
    __device__ __forceinline__ void operator()(const f32x4 (&acc)[2][2][4][2], const Unit& u, int wr, int wc, int fr, int fq) const {
        const int row0 = u.pm * BM + wr * 64 + fr, col0 = u.pn * BM + wc * 32 + 4 * fq;
#pragma unroll
        for (int ai = 0; ai < 2; ++ai)
#pragma unroll
            for (int m = 0; m < 4; ++m) { const size_t ro = (size_t)(row0 + ai * HALF + m * 16) * DM + col0;
#pragma unroll
                for (int bj = 0; bj < 2; ++bj)
#pragma unroll
                    for (int n = 0; n < 2; ++n) { const f32x4 xv = *(const f32x4*)(X + ro + bj * HALF + n * 16); *(f32x4*)(C + ro + bj * HALF + n * 16) = xv * DEEPNORM_ALPHA + acc[ai][bj][m][n]; } }
    }
};

template <class Epi, class Sched, bool ALIGN_EPI = false, bool SP2 = false>
__device__ __forceinline__ void gemm_phase(PG8_LAS unsigned char* lds, const Gemm g, const Sched& S, const Epi& E) {
    const int tid = threadIdx.x, wid = __builtin_amdgcn_readfirstlane(tid >> 6), lane = tid & 63, wr = wid >> 2, wc = wid & 3, fr = lane & 15, fq = lane >> 4;
    const int K = g.K, nt = K / BK;
    unsigned voffA[2], voffB[2];
#pragma unroll
    for (int i = 0; i < 2; ++i) { int R, C; stage_rc(tid * 16 + i * 8192, R, C); const int Rb = Epi::PERM ? ((R & ~31) + perm32(R & 31)) : R;
        voffA[i] = g.amode ? (unsigned)((((C >> 4) * 8192 + R) * 16 + (C & 15)) * 2) : (unsigned)(R * K + C) * 2u;
        voffB[i] = (unsigned)(Rb * K + C) * 2u; }
    const size_t kstepB = (size_t)(BK * 2), hstepB = (size_t)HALF * K * 2, tstepB = 2 * hstepB;
    const size_t kstepA = g.amode ? (size_t)4 * 8192 * 32 : (size_t)(BK * 2), hstepA = g.amode ? (size_t)HALF * 32 : (size_t)HALF * K * 2;
#define PG8_TILEA(pm) (g.amode ? (const char*)g.A + ((size_t)((pm) >> 5) * 64 * 8192 + (size_t)((pm) & 31) * 256) * 32 : (const char*)g.A + (size_t)(pm) * 2 * hstepA)
    const unsigned ldsw = (unsigned)wid * 1024u;
    const int aoff = lds_byte(wr * 64 + fr, fq * 8), boff = lds_byte(wc * 32 + fr, fq * 8);
#define PG8_SA(b, h) (((b) * 2 + (h)) * HTB)
#define PG8_SB(b, h) ((4 + (b) * 2 + (h)) * HTB)
#define PG8_STAGE(bufoff, gbase, voff) do { _Pragma("unroll") for (int _i = 0; _i < 2; ++_i) \
        __builtin_amdgcn_global_load_lds((const unsigned*)((const char*)(gbase) + (voff)[_i]), (PG8_LAS unsigned*)(lds + (bufoff) + ldsw + _i * 8192), 16, 0, 0); } while (0)
#define PG8_LDA(dst, b, h) do { _Pragma("unroll") for (int m = 0; m < 4; ++m) _Pragma("unroll") for (int k = 0; k < 2; ++k) dst[m][k] = *(const PG8_LAS bf16x8*)(lds + PG8_SA(b, h) + aoff + m * 2048 + k * 1024); } while (0)
#define PG8_LDB(dst, b, h) do { _Pragma("unroll") for (int n = 0; n < 2; ++n) _Pragma("unroll") for (int k = 0; k < 2; ++k) dst[n][k] = *(const PG8_LAS bf16x8*)(lds + PG8_SB(b, h) + boff + n * 2048 + k * 1024); } while (0)
#define PG8_MMA(ai, bj, At, Bt) do { __builtin_amdgcn_s_setprio(1); _Pragma("unroll") for (int m = 0; m < 4; ++m) _Pragma("unroll") for (int n = 0; n < 2; ++n) _Pragma("unroll") for (int k = 0; k < 2; ++k) \
        acc[ai][bj][m][n] = __builtin_amdgcn_mfma_f32_16x16x32_bf16(Bt[n][k], At[m][k], acc[ai][bj][m][n], 0, 0, 0); __builtin_amdgcn_s_setprio(0); } while (0)
#define PG8_WAIT_V(n) asm volatile("s_waitcnt vmcnt(" #n ")" ::: "memory")
#define PG8_WAIT_L(n) asm volatile("s_waitcnt lgkmcnt(" #n ")" ::: "memory")
#define PG8_BAR __builtin_amdgcn_s_barrier()
#define PG8_SCHED __builtin_amdgcn_sched_barrier(0)
    Unit cur, nxt; int ui = 0;
    if (!S.next(0, cur)) return;
    f32x4 acc[2][2][4][2];
#pragma unroll
    for (int a = 0; a < 2; ++a)
#pragma unroll
        for (int b = 0; b < 2; ++b)
#pragma unroll
            for (int m = 0; m < 4; ++m)
#pragma unroll
                for (int n = 0; n < 2; ++n) acc[a][b][m][n] = (f32x4){0.f, 0.f, 0.f, 0.f};
    bf16x8 At[4][2], B0[2][2], B1[2][2];
    const char* cA = PG8_TILEA(cur.pm); const char* cB = (const char*)g.Bt + (size_t)cur.pn * tstepB;
    S.a_ready(cur);
    if constexpr (SP2) {
        PG8_STAGE(PG8_SB(0, 0), cB, voffB); PG8_STAGE(PG8_SB(0, 1), cB + hstepB, voffB); PG8_STAGE(PG8_SA(0, 0), cA, voffA); PG8_STAGE(PG8_SA(0, 1), cA + hstepA, voffA);
        if (wr == 1) PG8_BAR;
        PG8_WAIT_V(2); PG8_BAR;
        PG8_STAGE(PG8_SB(1, 0), cB + kstepB, voffB); PG8_STAGE(PG8_SA(1, 0), cA + kstepA, voffA); PG8_STAGE(PG8_SB(1, 1), cB + hstepB + kstepB, voffB);
        PG8_WAIT_V(6); PG8_BAR;
    } else {
        PG8_STAGE(PG8_SB(0, 0), cB, voffB); PG8_STAGE(PG8_SA(0, 0), cA, voffA); PG8_STAGE(PG8_SB(0, 1), cB + hstepB, voffB); PG8_STAGE(PG8_SA(0, 1), cA + hstepA, voffA);
        if (wr == 1) PG8_BAR;
        PG8_WAIT_V(4); PG8_BAR;
        PG8_STAGE(PG8_SB(1, 0), cB + kstepB, voffB); PG8_STAGE(PG8_SA(1, 0), cA + kstepA, voffA); PG8_STAGE(PG8_SB(1, 1), cB + hstepB + kstepB, voffB);
        PG8_WAIT_V(6); PG8_BAR;
    }
    for (;;) {
        const bool has_next = S.next(ui + 1, nxt);
        const char* nA = has_next ? PG8_TILEA(nxt.pm) : cA; const char* nB = has_next ? (const char*)g.Bt + (size_t)nxt.pn * tstepB : cB;
        for (int t = 0; t < nt; t += 2) {
            const bool last = (t == nt - 2);
            const char* a1 = cA + (size_t)(t + 1) * kstepA;
            const char* a2 = last ? nA : cA + (size_t)(t + 2) * kstepA; const char* b2 = last ? nB : cB + (size_t)(t + 2) * kstepB;
            const char* a3 = a2 + kstepA; const char* b3 = b2 + kstepB;
            if (last && has_next) S.a_ready(nxt);
            if constexpr (SP2) {
            PG8_LDB(B0, 0, 0); PG8_LDB(B1, 0, 1); PG8_SCHED; PG8_LDA(At, 0, 0); PG8_STAGE(PG8_SA(1, 1), a1 + hstepA, voffA);
            PG8_WAIT_V(8); PG8_WAIT_L(0); PG8_BAR; PG8_MMA(0, 0, At, B0); PG8_MMA(0, 1, At, B1); PG8_BAR; PG8_SCHED;
            PG8_LDA(At, 0, 1); PG8_STAGE(PG8_SB(0, 0), b2, voffB); PG8_STAGE(PG8_SB(0, 1), b2 + hstepB, voffB); PG8_STAGE(PG8_SA(0, 0), a2, voffA);
            PG8_WAIT_V(8); PG8_WAIT_L(0); PG8_BAR; PG8_MMA(1, 0, At, B0); PG8_MMA(1, 1, At, B1); PG8_BAR; PG8_SCHED;
            PG8_LDB(B0, 1, 0); PG8_LDB(B1, 1, 1); PG8_SCHED; PG8_LDA(At, 1, 0); PG8_STAGE(PG8_SA(0, 1), a2 + hstepA, voffA);
            PG8_WAIT_V(8); PG8_WAIT_L(0); PG8_BAR; PG8_MMA(0, 0, At, B0); PG8_MMA(0, 1, At, B1); PG8_BAR; PG8_SCHED;
            PG8_LDA(At, 1, 1); PG8_STAGE(PG8_SB(1, 0), b3, voffB); PG8_STAGE(PG8_SB(1, 1), b3 + hstepB, voffB); PG8_STAGE(PG8_SA(1, 0), a3, voffA);
            PG8_WAIT_V(8); PG8_WAIT_L(0); PG8_BAR; PG8_MMA(1, 0, At, B0); PG8_MMA(1, 1, At, B1); PG8_BAR; PG8_SCHED;
            } else {
            PG8_LDB(B0, 0, 0); PG8_SCHED; PG8_LDA(At, 0, 0); PG8_STAGE(PG8_SA(1, 1), a1 + hstepA, voffA);
            PG8_WAIT_L(8); PG8_BAR; PG8_WAIT_L(0); PG8_MMA(0, 0, At, B0); PG8_BAR; PG8_SCHED;
            PG8_LDB(B1, 0, 1); PG8_STAGE(PG8_SB(0, 0), b2, voffB);
            PG8_BAR; PG8_WAIT_L(0); PG8_MMA(0, 1, At, B1); PG8_BAR;
            PG8_LDA(At, 0, 1); PG8_STAGE(PG8_SA(0, 0), a2, voffA);
            PG8_BAR; PG8_WAIT_L(0); PG8_MMA(1, 0, At, B0); PG8_BAR; PG8_SCHED;
            PG8_STAGE(PG8_SB(0, 1), b2 + hstepB, voffB);
            PG8_WAIT_V(6); PG8_BAR; PG8_MMA(1, 1, At, B1); PG8_BAR;
            PG8_LDB(B0, 1, 0); PG8_SCHED; PG8_LDA(At, 1, 0); PG8_STAGE(PG8_SA(0, 1), a2 + hstepA, voffA);
            PG8_WAIT_L(8); PG8_BAR; PG8_WAIT_L(0); PG8_MMA(0, 0, At, B0); PG8_BAR; PG8_SCHED;
            PG8_LDB(B1, 1, 1); PG8_STAGE(PG8_SB(1, 0), b3, voffB);
            PG8_BAR; PG8_WAIT_L(0); PG8_MMA(0, 1, At, B1); PG8_BAR;
            PG8_LDA(At, 1, 1); PG8_STAGE(PG8_SA(1, 0), a3, voffA);
            PG8_BAR; PG8_WAIT_L(0); PG8_MMA(1, 0, At, B0); PG8_BAR; PG8_SCHED;
            PG8_STAGE(PG8_SB(1, 1), b3 + hstepB, voffB);
            PG8_WAIT_V(6); PG8_BAR; PG8_MMA(1, 1, At, B1); PG8_BAR;
            }
        }
        if constexpr (ALIGN_EPI) { if (wr == 0) PG8_BAR; }
        if constexpr (!Epi::AFTER_DRAIN) { E(acc, cur, wr, wc, fr, fq); S.done(cur); }
        if (!has_next) break;
#pragma unroll
        for (int a = 0; a < 2; ++a)
#pragma unroll
            for (int b = 0; b < 2; ++b)
#pragma unroll
                for (int m = 0; m < 4; ++m)
#pragma unroll
                    for (int n = 0; n < 2; ++n) acc[a][b][m][n] = (f32x4){0.f, 0.f, 0.f, 0.f};
        cur = nxt; cA = nA; cB = nB; ++ui;
        if constexpr (ALIGN_EPI) { if (wr == 1) PG8_BAR; }
    }
    PG8_WAIT_V(0);
    if constexpr (!ALIGN_EPI) { if (wr == 0) PG8_BAR; }
    PG8_BAR;
#undef PG8_TILEA
#undef PG8_SA
#undef PG8_SB
#undef PG8_STAGE
#undef PG8_LDA
#undef PG8_LDB
#undef PG8_MMA
#undef PG8_WAIT_V
#undef PG8_WAIT_L
#undef PG8_BAR
#undef PG8_SCHED
}
}

constexpr int NWAVES = 8;
constexpr int N_PHASES = 8;
constexpr size_t MiB = 1u << 20;
constexpr size_t WS_CTL = 0;
constexpr size_t WS_BIAS = 64 * 1024;
constexpr size_t WS_WIN = 1 * MiB;
constexpr size_t WS_WGLU = 36 * MiB;
constexpr size_t WS_WBS = 40 * MiB, WS_WBA = 44 * MiB;
constexpr size_t WS_WOUT = 48 * MiB;
constexpr size_t WS_XB = 64 * MiB;
constexpr size_t WS_U = 192 * MiB;
constexpr size_t WS_ZS = 256 * MiB;
constexpr size_t WS_Q = 320 * MiB;
constexpr size_t WS_K = 384 * MiB, WS_V = 400 * MiB;
constexpr size_t WS_ZA = 416 * MiB;
constexpr size_t WS_GS = 480 * MiB, WS_GA = 608 * MiB;
constexpr size_t WS_Y = 736 * MiB;
constexpr size_t WS_HA = 800 * MiB;
constexpr size_t WS_END = 864 * MiB;

constexpr int RING_BYTES = 131072, LDS_BYTES = 147456;

#define GAS __attribute__((address_space(1)))
#define LAS __attribute__((address_space(3)))
typedef unsigned short bf16;
typedef unsigned v4u __attribute__((ext_vector_type(4)));
typedef float f32x4 __attribute__((ext_vector_type(4)));
#define LDS_WAIT() asm volatile("s_waitcnt lgkmcnt(0)" ::: "memory")
__device__ __forceinline__ unsigned f2bf(float f) { unsigned u = __builtin_bit_cast(unsigned, f); return (u + 0x7fffu + ((u >> 16) & 1u)) >> 16; }
__device__ __forceinline__ unsigned pk2(float lo, float hi) { return f2bf(lo) | (f2bf(hi) << 16); }
__device__ __forceinline__ float bf2f(unsigned short h) { return __uint_as_float(((unsigned)h) << 16); }

__device__ __forceinline__ void p0_transpose_item(const float* W, int K, int N, bf16* WT, int k0, int n0, int wt_row0, LAS float* scr, int lane) {
#pragma unroll 8
    for (int i = 0; i < 32; ++i) { const int kk = 2 * i + (lane >> 5); scr[kk * 33 + (lane & 31)] = W[(size_t)(k0 + kk) * N + n0 + (lane & 31)]; }
    LDS_WAIT(); asm volatile("" ::: "memory");
    const int c = lane & 7;
#pragma unroll
    for (int j = 0; j < 4; ++j) { const int n = (lane >> 3) + 8 * j; const LAS float* s = scr + (8 * c) * 33 + n;
        v4u o; o.x = pk2(s[0 * 33], s[1 * 33]); o.y = pk2(s[2 * 33], s[3 * 33]); o.z = pk2(s[4 * 33], s[5 * 33]); o.w = pk2(s[6 * 33], s[7 * 33]);
        *(GAS v4u*)(WT + (size_t)(wt_row0 + n) * K + k0 + 8 * c) = o; }
    LDS_WAIT(); asm volatile("" ::: "memory");
}

__device__ __forceinline__ int t5_bucket(int dist) {
    if (dist < 16) return dist;
    const float d = (float)dist;
    int large = 16 + (int)(logf(d / 16.0f) / logf(8.0f) * 16.0f);
    return large < 31 ? large : 31;
}

struct Args { const float* in[18]; float* out; unsigned char* ws; int ph_lo, ph_hi; };

__device__ __forceinline__ void ssm_simple_unit(const Args& a, int unit, int lane) {
    const int b = unit >> 6, g = unit & 63, p = lane;
    const float* lam_re = a.in[2]; const float* lam_im = a.in[3]; const float* b_re = a.in[4]; const float* b_im = a.in[5];
    const float* c_re = a.in[6]; const float* c_im = a.in[7]; const float* dsk = a.in[8]; const float* lstep = a.in[9];
    const float step = expf(lstep[g]);
    const float lr = lam_re[g * 64 + p], li = lam_im[g * 64 + p];
    const float mag = expf(lr * step); float sn, cs; sincosf(li * step, &sn, &cs);
    const float ar = mag * cs, ai = mag * sn;
    const float nr = ar - 1.0f, ni = ai, den = lr * lr + li * li;
    const float fr = (nr * lr + ni * li) / den, fi = (ni * lr - nr * li) / den;
    float bbr[16], bbi[16], cr[16], ci[16], dd[16];
#pragma unroll
    for (int h = 0; h < 16; ++h) { const float br = b_re[(g * 64 + p) * 16 + h], bi = b_im[(g * 64 + p) * 16 + h];
        bbr[h] = fr * br - fi * bi; bbi[h] = fr * bi + fi * br;
        cr[h] = c_re[(g * 16 + h) * 64 + p]; ci[h] = c_im[(g * 16 + h) * 64 + p]; dd[h] = dsk[g * 16 + h]; }
    const bf16* U = (const bf16*)(a.ws + WS_U) + (size_t)(b * 64 + g) * 8192 * 16;
    bf16* Y = (bf16*)(a.ws + WS_Y) + (size_t)(b * 64 + g) * 8192 * 16;
    const int hown = 8 * (lane & 1) + 4 * ((lane >> 1) & 1) + 2 * ((lane >> 2) & 1) + ((lane >> 3) & 1);
    float sr = 0.f, si = 0.f;
    for (int t = 0; t < 8192; ++t) {
        const v4u u0 = *(const v4u*)(U + (size_t)t * 16), u1 = *(const v4u*)(U + (size_t)t * 16 + 8);
        float u[16] = {pg8::bf_lo(u0.x), pg8::bf_hi(u0.x), pg8::bf_lo(u0.y), pg8::bf_hi(u0.y), pg8::bf_lo(u0.z), pg8::bf_hi(u0.z), pg8::bf_lo(u0.w), pg8::bf_hi(u0.w),
                       pg8::bf_lo(u1.x), pg8::bf_hi(u1.x), pg8::bf_lo(u1.y), pg8::bf_hi(u1.y), pg8::bf_lo(u1.z), pg8::bf_hi(u1.z), pg8::bf_lo(u1.w), pg8::bf_hi(u1.w)};
        float bur = 0.f, bui = 0.f;
#pragma unroll
        for (int h = 0; h < 16; ++h) { bur += bbr[h] * u[h]; bui += bbi[h] * u[h]; }
        const float nsr = ar * sr - ai * si + bur, nsi = ar * si + ai * sr + bui; sr = nsr; si = nsi;
        float z[16];
#pragma unroll
        for (int h = 0; h < 16; ++h) z[h] = cr[h] * sr - ci[h] * si;
#pragma unroll
        for (int i = 0; i < 8; ++i) { const bool up = (lane & 1) != 0; const float send = up ? z[i] : z[i + 8], keep = up ? z[i + 8] : z[i]; z[i] = keep + __shfl_xor(send, 1); }
#pragma unroll
        for (int i = 0; i < 4; ++i) { const bool up = (lane & 2) != 0; const float send = up ? z[i] : z[i + 4], keep = up ? z[i + 4] : z[i]; z[i] = keep + __shfl_xor(send, 2); }
#pragma unroll
        for (int i = 0; i < 2; ++i) { const bool up = (lane & 4) != 0; const float send = up ? z[i] : z[i + 2], keep = up ? z[i + 2] : z[i]; z[i] = keep + __shfl_xor(send, 4); }
        { const bool up = (lane & 8) != 0; const float send = up ? z[0] : z[1], keep = up ? z[1] : z[0]; z[0] = keep + __shfl_xor(send, 8); }
        float tot = z[0]; tot += __shfl_xor(tot, 16); tot += __shfl_xor(tot, 32);
        float uo = 0.f, dv = 0.f;
#pragma unroll
        for (int h = 0; h < 16; ++h) { if (h == hown) { uo = u[h]; dv = dd[h]; } }
        const float y = tot + dv * uo;
        if (lane < 16) Y[(size_t)t * 16 + hown] = (bf16)f2bf(pg8::gelu_f(y));
    }
}

__device__ __forceinline__ void attn_simple_item(const Args& a, int item) {
    const int row = item >> 4, h = item & 15, kvh = h >> 2, t = row & 8191;
    const bf16* Q = (const bf16*)(a.ws + WS_Q); const bf16* Kb = (const bf16*)(a.ws + WS_K); const bf16* Vb = (const bf16*)(a.ws + WS_V);
    const bf16* ZA = (const bf16*)(a.ws + WS_ZA); bf16* HA = (bf16*)(a.ws + WS_HA);
    const float* biasd = (const float*)(a.ws + WS_BIAS) + h * 128;
    float q[64], o[64];
#pragma unroll
    for (int c = 0; c < 8; ++c) { const v4u w = *(const v4u*)(Q + (size_t)row * 1024 + h * 64 + c * 8);
        q[c * 8 + 0] = pg8::bf_lo(w.x); q[c * 8 + 1] = pg8::bf_hi(w.x); q[c * 8 + 2] = pg8::bf_lo(w.y); q[c * 8 + 3] = pg8::bf_hi(w.y);
        q[c * 8 + 4] = pg8::bf_lo(w.z); q[c * 8 + 5] = pg8::bf_hi(w.z); q[c * 8 + 6] = pg8::bf_lo(w.w); q[c * 8 + 7] = pg8::bf_hi(w.w); }
#pragma unroll
    for (int d = 0; d < 64; ++d) o[d] = 0.f;
    float mx = a.in[11][h] * LOG2E, l = 1.0f;
    const int nd = t < 127 ? t : 127;
    for (int dist = 0; dist <= nd; ++dist) {
        const size_t kr = (size_t)(row - dist) * 256 + kvh * 64;
        float s = 0.f;
#pragma unroll
        for (int c = 0; c < 8; ++c) { const v4u w = *(const v4u*)(Kb + kr + c * 8);
            s += q[c * 8 + 0] * pg8::bf_lo(w.x) + q[c * 8 + 1] * pg8::bf_hi(w.x) + q[c * 8 + 2] * pg8::bf_lo(w.y) + q[c * 8 + 3] * pg8::bf_hi(w.y)
               + q[c * 8 + 4] * pg8::bf_lo(w.z) + q[c * 8 + 5] * pg8::bf_hi(w.z) + q[c * 8 + 6] * pg8::bf_lo(w.w) + q[c * 8 + 7] * pg8::bf_hi(w.w); }
        s += biasd[dist];
        const float mn = fmaxf(mx, s), sc = exp2f(mx - mn), pr = exp2f(s - mn);
        l = l * sc + pr; mx = mn;
#pragma unroll
        for (int c = 0; c < 8; ++c) { const v4u w = *(const v4u*)(Vb + kr + c * 8);
            o[c * 8 + 0] = o[c * 8 + 0] * sc + pr * pg8::bf_lo(w.x); o[c * 8 + 1] = o[c * 8 + 1] * sc + pr * pg8::bf_hi(w.x);
            o[c * 8 + 2] = o[c * 8 + 2] * sc + pr * pg8::bf_lo(w.y); o[c * 8 + 3] = o[c * 8 + 3] * sc + pr * pg8::bf_hi(w.y);
            o[c * 8 + 4] = o[c * 8 + 4] * sc + pr * pg8::bf_lo(w.z); o[c * 8 + 5] = o[c * 8 + 5] * sc + pr * pg8::bf_hi(w.z);
            o[c * 8 + 6] = o[c * 8 + 6] * sc + pr * pg8::bf_lo(w.w); o[c * 8 + 7] = o[c * 8 + 7] * sc + pr * pg8::bf_hi(w.w); }
    }
    const float rl = 1.0f / l;
#pragma unroll
    for (int c = 0; c < 8; ++c) { const size_t off = (size_t)row * 1024 + h * 64 + c * 8; const v4u z = *(const v4u*)(ZA + off);
        v4u w; w.x = pk2(o[c * 8 + 0] * rl * pg8::bf_lo(z.x), o[c * 8 + 1] * rl * pg8::bf_hi(z.x)); w.y = pk2(o[c * 8 + 2] * rl * pg8::bf_lo(z.y), o[c * 8 + 3] * rl * pg8::bf_hi(z.y));
        w.z = pk2(o[c * 8 + 4] * rl * pg8::bf_lo(z.z), o[c * 8 + 5] * rl * pg8::bf_hi(z.z)); w.w = pk2(o[c * 8 + 6] * rl * pg8::bf_lo(z.w), o[c * 8 + 7] * rl * pg8::bf_hi(z.w));
        *(v4u*)(HA + off) = w; }
}

__device__ __forceinline__ float wave_sum(float v) {
#pragma unroll
    for (int o = 1; o < 64; o <<= 1) v += __shfl_xor(v, o);
    return v;
}

__global__ void __launch_bounds__(NWAVES * 64, 2) fwd_megakernel(Args args) {
    extern __shared__ __attribute__((aligned(16))) unsigned char lds[];
    cg::grid_group grid = cg::this_grid();
    const int tid = threadIdx.x, lane = tid & 63, wave = __builtin_amdgcn_readfirstlane(tid >> 6);
    const int G = gridDim.x, bx = blockIdx.x;
    const int vcu = (G % 8 == 0) ? (bx % 8) * (G / 8) + bx / 8 : bx;
    unsigned char* ws = args.ws;
    const int lo = args.ph_lo, hi = args.ph_hi;
#define IN(k) (lo <= (k) && (k) < hi)
#define SEAM(k) do { if (IN(k) && IN((k) + 1)) grid.sync(); } while (0)
    LAS unsigned char* ldsl = (LAS unsigned char*)lds;
    const int gw = vcu * NWAVES + wave, NGW = G * NWAVES;
    const int gt = vcu * (NWAVES * 64) + tid, NGT = G * NWAVES * 64;

    if (IN(0)) {
        { const float* x = args.in[0]; bf16* xb = (bf16*)(ws + WS_XB);
          for (size_t i = (size_t)gt; i < (size_t)M * DM / 8; i += NGT) { const f32x4 a = *(const f32x4*)(x + i * 8), b = *(const f32x4*)(x + i * 8 + 4);
              v4u o; o.x = pk2(a[0], a[1]); o.y = pk2(a[2], a[3]); o.z = pk2(b[0], b[1]); o.w = pk2(b[2], b[3]); *(v4u*)(xb + i * 8) = o; } }
        { LAS float* scr = (LAS float*)(ldsl + wave * 16384);
          constexpr int I_IN = (DM / 64) * (D_IN / 32), I_GLU = (D_SSM / 64) * (2048 / 32), I_BS = I_GLU, I_BA = I_GLU, I_OUT = (DM / 64) * (DM / 32);
          constexpr int NITEMS = I_IN + I_GLU + I_BS + I_BA + I_OUT;
          for (int it = gw; it < NITEMS; it += NGW) {
              int r = it;
              if (r < I_IN) { const int nblk = D_IN / 32, kb = r / nblk, nb = r % nblk; p0_transpose_item(args.in[1], DM, D_IN, (bf16*)(ws + WS_WIN), 64 * kb, 32 * nb, 32 * nb, scr, lane); continue; } r -= I_IN;
              if (r < I_GLU) { const int nblk = 2048 / 32, kb = r / nblk, nb = r % nblk, n0 = 32 * nb;
                  const int wrow = 256 * ((n0 & 1023) >> 7) + 128 * (n0 >> 10) + (n0 & 127);
                  p0_transpose_item(args.in[10], D_SSM, 2048, (bf16*)(ws + WS_WGLU), 64 * kb, n0, wrow, scr, lane); continue; } r -= I_GLU;
              if (r < I_BS) { const int nblk = 2048 / 32, kb = r / nblk, nb = r % nblk; p0_transpose_item(args.in[13], D_SSM, DM, (bf16*)(ws + WS_WBS), 64 * kb, 32 * nb, 32 * nb, scr, lane); continue; } r -= I_BS;
              if (r < I_BA) { const int nblk = 2048 / 32, kb = r / nblk, nb = r % nblk; p0_transpose_item(args.in[14], D_ATTN, DM, (bf16*)(ws + WS_WBA), 64 * kb, 32 * nb, 32 * nb, scr, lane); continue; } r -= I_BA;
              { const int nblk = DM / 32, kb = r / nblk, nb = r % nblk; p0_transpose_item(args.in[15], DM, DM, (bf16*)(ws + WS_WOUT), 64 * kb, 32 * nb, 32 * nb, scr, lane); }
          } }
        if (gt < 16 * 128) { const int h = gt >> 7, dist = gt & 127; ((float*)(ws + WS_BIAS))[gt] = args.in[12][t5_bucket(dist) * 16 + h] * LOG2E; }
        __syncthreads();
    }
    SEAM(0);

    if (IN(1)) {
        pg8::Gemm g{(const bf16*)(ws + WS_XB), (const bf16*)(ws + WS_WIN), DM, 0}; pg8::StaticOrder S; S.init(M, D_IN, G, bx);
        pg8::EpiInProj E{(bf16*)(ws + WS_U), (bf16*)(ws + WS_ZS), (bf16*)(ws + WS_Q), (bf16*)(ws + WS_K), (bf16*)(ws + WS_V), (bf16*)(ws + WS_ZA), (bf16*)(ws + WS_GS), (bf16*)(ws + WS_GA)};
        pg8::gemm_phase<pg8::EpiInProj, pg8::StaticOrder, true, true>(ldsl, g, S, E);
    }
    SEAM(1);

    if (IN(2)) {
        if (wave == 0) { for (int unit = vcu; unit < BATCH * NG; unit += G) ssm_simple_unit(args, unit, lane); }
        else { const int at = vcu * 448 + (tid - 64), NAT = G * 448; for (int item = at; item < M * NQH; item += NAT) attn_simple_item(args, item); }
        __syncthreads();
    }
    SEAM(2);

    if (IN(3)) {
        pg8::Gemm g{(const bf16*)(ws + WS_Y), (const bf16*)(ws + WS_WGLU), D_SSM, 1}; pg8::StaticOrder S; S.init(M, 2048, G, bx);
        pg8::EpiGlu E{(const bf16*)(ws + WS_ZS), (bf16*)(ws + WS_Q)};
        pg8::gemm_phase<pg8::EpiGlu, pg8::StaticOrder, true, true>(ldsl, g, S, E);
    }
    SEAM(3);

    if (IN(4)) {
        pg8::Gemm g{(const bf16*)(ws + WS_Q), (const bf16*)(ws + WS_WBS), D_SSM, 0}; pg8::StaticOrder S; S.init(M, DM, G, bx);
        pg8::EpiGate<false> E{(const bf16*)(ws + WS_GS), (bf16*)(ws + WS_XB)};
        pg8::gemm_phase<pg8::EpiGate<false>, pg8::StaticOrder, true, true>(ldsl, g, S, E);
    }
    SEAM(4);

    if (IN(5)) {
        pg8::Gemm g{(const bf16*)(ws + WS_HA), (const bf16*)(ws + WS_WBA), D_ATTN, 0}; pg8::StaticOrder S; S.init(M, DM, G, bx);
        pg8::EpiGate<true> E{(const bf16*)(ws + WS_GA), (bf16*)(ws + WS_XB)};
        pg8::gemm_phase<pg8::EpiGate<true>, pg8::StaticOrder, true, true>(ldsl, g, S, E);
    }
    SEAM(5);

    if (IN(6)) {
        pg8::Gemm g{(const bf16*)(ws + WS_XB), (const bf16*)(ws + WS_WOUT), DM, 0}; pg8::StaticOrder S; S.init(M, DM, G, bx);
        pg8::EpiResid E{args.in[0], args.out};
        pg8::gemm_phase<pg8::EpiResid, pg8::StaticOrder, true, true>(ldsl, g, S, E);
    }
    SEAM(6);

    if (IN(7)) {
        const float* gain = args.in[16]; const float* bias = args.in[17];
        for (int m = gw; m < M; m += NGW) {
            GAS f32x4* xr = (GAS f32x4*)(args.out + (size_t)m * DM) + lane;
            f32x4 v[8]; float s = 0.f;
#pragma unroll
            for (int j = 0; j < 8; ++j) { v[j] = xr[64 * j]; s += (v[j].x + v[j].y) + (v[j].z + v[j].w); }
            const float mean = wave_sum(s) * (1.f / DM); float s2 = 0.f;
#pragma unroll
            for (int j = 0; j < 8; ++j) { v[j] = v[j] - mean; s2 += (v[j].x * v[j].x + v[j].y * v[j].y) + (v[j].z * v[j].z + v[j].w * v[j].w); }
            const float rstd = 1.f / sqrtf(wave_sum(s2) * (1.f / DM) + LN_EPS);
#pragma unroll
            for (int j = 0; j < 8; ++j) { const f32x4 gn = *(const f32x4*)(gain + (64 * j + lane) * 4), bs = *(const f32x4*)(bias + (64 * j + lane) * 4); xr[64 * j] = v[j] * rstd * gn + bs; }
        }
    }
#undef IN
#undef SEAM
}

extern "C" void kernel_launch(void* const* d_in, const int* in_sizes, int n_in, void* d_out, int out_size, void* d_ws, size_t ws_size, hipStream_t stream) {
    static int grid = 0;
    if (grid == 0) {
        if (n_in != 18 || in_sizes[0] != M * DM || out_size != M * DM || ws_size < WS_END) { fprintf(stderr, "kernel_launch: unexpected shapes (n_in %d, in0 %d, out %d, ws %zu); nothing launched\n", n_in, n_in > 0 ? in_sizes[0] : -1, out_size, ws_size); grid = -1; return; }
        int dev = 0, cus = 0, per_cu = 0;
        if (hipGetDevice(&dev) != hipSuccess || hipDeviceGetAttribute(&cus, hipDeviceAttributeMultiprocessorCount, dev) != hipSuccess) { grid = -1; return; }
        if (hipFuncSetAttribute((const void*)fwd_megakernel, hipFuncAttributeMaxDynamicSharedMemorySize, LDS_BYTES) != hipSuccess) { fprintf(stderr, "kernel_launch: hipFuncSetAttribute failed\n"); grid = -1; return; }
        if (hipOccupancyMaxActiveBlocksPerMultiprocessor(&per_cu, (const void*)fwd_megakernel, NWAVES * 64, LDS_BYTES) != hipSuccess || per_cu < 1) { fprintf(stderr, "kernel_launch: occupancy query says %d\n", per_cu); per_cu = 1; }
        (void)hipGetLastError();
        grid = cus * 1;
    }
    if (grid < 0) return;
    Args a{};
    for (int i = 0; i < 18; ++i) a.in[i] = (const float*)d_in[i];
    a.out = (float*)d_out; a.ws = (unsigned char*)d_ws;
#if MK_N_LAUNCHES == 1
    a.ph_lo = 0; a.ph_hi = N_PHASES;
    void* kargs[] = {&a};
    hipError_t e = hipLaunchCooperativeKernel((const void*)fwd_megakernel, dim3(grid), dim3(NWAVES * 64), kargs, LDS_BYTES, stream);
    if (e != hipSuccess) fprintf(stderr, "cooperative launch failed: %s (grid %d)\n", hipGetErrorString(e), grid);
#else
    for (int p = 0; p < N_PHASES; ++p) { a.ph_lo = p; a.ph_hi = p + 1; hipLaunchKernelGGL(fwd_megakernel, dim3(grid), dim3(NWAVES * 64), LDS_BYTES, stream, a); }
#endif
}
```

```cpp
#include <hip/hip_runtime.h>
#include <hip/hip_cooperative_groups.h>
#include <cstdio>
#include <cstdint>
namespace cg = cooperative_groups;

#ifndef MK_N_LAUNCHES
#define MK_N_LAUNCHES 1
#endif

constexpr int BATCH = 4, SEQ = 8192, DM = 2048, M = BATCH * SEQ;
constexpr int D_SSM = 1024, NG = 64, GRP = 16, NST = 64;
constexpr int NQH = 16, NKVH = 4, HD = 64, D_ATTN = 1024, D_KV = 256;
constexpr int D_IN = 8704;
constexpr float LN_EPS = 1e-5f;
constexpr float LOG2E = 1.4426950408889634f;
#define DEEPNORM_ALPHA 1.189207115002721f

namespace pg8 {
#define PG8_LAS __attribute__((address_space(3)))
typedef unsigned short bf16_t;
typedef short bf16x8 __attribute__((ext_vector_type(8)));
typedef float f32x4 __attribute__((ext_vector_type(4)));
typedef unsigned u32x4 __attribute__((ext_vector_type(4)));
constexpr int BM = 256, BK = 64, HALF = 128, HTB = HALF * BK * 2, STAGE_BYTES = 8 * HTB, NXCD = 8, WGM = 8;

__host__ __device__ __forceinline__ int lds_byte(int r, int c) { const int st = (r >> 4) * 2 + (c >> 5), rr = r & 15, cc = c & 31, ob = rr * 64 + cc * 2; return st * 1024 + (ob ^ (((ob >> 9) & 1) << 5)); }
__host__ __device__ __forceinline__ void stage_rc(int b, int& R, int& C) { const int st = b / 1024, sb = b % 1024, swz = sb ^ (((sb >> 9) & 1) << 5); R = (st >> 1) * 16 + swz / 64; C = (st & 1) * 32 + (swz % 64) / 2; }
__host__ __device__ __forceinline__ int perm32(int rho) { const int n = rho >> 4, i = rho & 15; return 8 * (i >> 2) + 4 * n + (i & 3); }

struct Unit { int pm, pn; };
struct Gemm { const bf16_t* A; const bf16_t* Bt; int K; int amode; };

struct StaticOrder {
    int nM, nN, nwg, G, c;
    __host__ __device__ void init(int M_, int N_, int G_, int c_) { nM = M_ / BM; nN = N_ / BM; nwg = nM * nN; G = G_; c = c_; }
    __host__ __device__ bool next(int i, Unit& u) const {
        const long L = (long)i * G + c; if (L >= nwg) return false;
        int wgid = (int)L; { const int q = nwg / NXCD, r = nwg % NXCD, xcd = wgid % NXCD, off = wgid / NXCD; wgid = (xcd < r ? xcd * (q + 1) : r * (q + 1) + (xcd - r) * q) + off; }
        const int nig = WGM * nN, gid = wgid / nig, fm = gid * WGM, gsz = (nM - fm) < WGM ? (nM - fm) : WGM;
        u.pm = fm + ((wgid % nig) % gsz); u.pn = (wgid % nig) / gsz; return true;
    }
    __device__ __forceinline__ void a_ready(const Unit&) const {}
    __device__ __forceinline__ void done(const Unit&) const {}
};

typedef float f32x2_t __attribute__((ext_vector_type(2))); typedef __bf16 bf16x2_t __attribute__((ext_vector_type(2)));
__device__ __forceinline__ unsigned cvt_pk_bf16(float lo, float hi) { f32x2_t v = {lo, hi}; bf16x2_t b = __builtin_convertvector(v, bf16x2_t); return __builtin_bit_cast(unsigned, b); }
__device__ __forceinline__ float bf_lo(unsigned w) { return __uint_as_float(w << 16); }
__device__ __forceinline__ float bf_hi(unsigned w) { return __uint_as_float(w & 0xffff0000u); }
__device__ __forceinline__ float sigmoid_f(float x) { return __builtin_amdgcn_rcpf(1.0f + __builtin_amdgcn_exp2f(-x * LOG2E)); }
__device__ __forceinline__ float silu_f(float x) { return x * sigmoid_f(x); }
__device__ __forceinline__ float gelu_f(float v) {
    const float av = __builtin_fabsf(v), d = av * 0.2316418882f + 1.0f, t = __builtin_amdgcn_rcpf(d);
    float q = t * 0.5307027145f + (-0.7265760135f); q = q * t + 0.7107068705f; q = q * t + (-0.142248368f); q = q * t + 0.127414796f; q = q * t;
    const float e = __builtin_amdgcn_exp2f((v * v) * (-0.72134752044f));
    const float m = v * (q * e);
    return v < 0.f ? m : v - m;
}

template <int ACT> __device__ __forceinline__ float act_f(float v) {
    if (ACT == 1) return silu_f(v);
    if (ACT == 2) return v * (0.125f * LOG2E);
    if (ACT == 3) return sigmoid_f(v);
    return v;
}
template <int ACT, bool GM> __device__ __forceinline__ void store_tile_bf16(const f32x4 (&acc)[2][2][4][2], bf16_t* base, int ld, int row0, int col0) {
#pragma unroll
    for (int ai = 0; ai < 2; ++ai)
#pragma unroll
        for (int m = 0; m < 4; ++m) { const int row = row0 + ai * HALF + m * 16;
#pragma unroll
            for (int bj = 0; bj < 2; ++bj) { const int col = col0 + bj * HALF; const f32x4 v0 = acc[ai][bj][m][0], v1 = acc[ai][bj][m][1];
                u32x4 w; w.x = cvt_pk_bf16(act_f<ACT>(v0[0]), act_f<ACT>(v0[1])); w.y = cvt_pk_bf16(act_f<ACT>(v0[2]), act_f<ACT>(v0[3]));
                w.z = cvt_pk_bf16(act_f<ACT>(v1[0]), act_f<ACT>(v1[1])); w.w = cvt_pk_bf16(act_f<ACT>(v1[2]), act_f<ACT>(v1[3]));
                bf16_t* p = GM ? base + ((size_t)((row >> 13) * 64 + (col >> 4)) * 8192 + (row & 8191)) * 16 + (col & 15) : base + (size_t)row * ld + col;
                *(u32x4*)p = w; } }
}
struct EpiInProj {
    static constexpr bool PERM = true, AFTER_DRAIN = false;
    bf16_t *U, *ZS, *Q, *Kb, *Vb, *ZA, *GS, *GA;
    __device__ __forceinline__ void operator()(const f32x4 (&acc)[2][2][4][2], const Unit& u, int wr, int wc, int fr, int fq) const {
        const int pn = u.pn, row0 = u.pm * BM + wr * 64 + fr, cw = wc * 32 + 8 * fq;
        if (pn < 4)        store_tile_bf16<0, true >(acc, U, 0, row0, pn * 256 + cw);
        else if (pn < 8)   store_tile_bf16<1, false>(acc, ZS, 1024, row0, (pn - 4) * 256 + cw);
        else if (pn < 12)  store_tile_bf16<2, false>(acc, Q, 1024, row0, (pn - 8) * 256 + cw);
        else if (pn == 12) store_tile_bf16<0, false>(acc, Kb, 256, row0, cw);
        else if (pn == 13) store_tile_bf16<0, false>(acc, Vb, 256, row0, cw);
        else if (pn < 18)  store_tile_bf16<1, false>(acc, ZA, 1024, row0, (pn - 14) * 256 + cw);
        else if (pn < 26)  store_tile_bf16<3, false>(acc, GS, 2048, row0, (pn - 18) * 256 + cw);
        else               store_tile_bf16<3, false>(acc, GA, 2048, row0, (pn - 26) * 256 + cw);
    }
};
struct EpiGlu {
    static constexpr bool PERM = true, AFTER_DRAIN = false;
    const bf16_t* ZS; bf16_t* HS;
    __device__ __forceinline__ void operator()(const f32x4 (&acc)[2][2][4][2], const Unit& u, int wr, int wc, int fr, int fq) const {
        const int row0 = u.pm * BM + wr * 64 + fr, j0 = u.pn * 128 + wc * 32 + 8 * fq;
#pragma unroll
        for (int ai = 0; ai < 2; ++ai)
#pragma unroll
            for (int m = 0; m < 4; ++m) { const size_t off = (size_t)(row0 + ai * HALF + m * 16) * 1024 + j0;
                const u32x4 z = *(const u32x4*)(ZS + off);
                const f32x4 a0 = acc[ai][0][m][0], a1 = acc[ai][0][m][1], b0 = acc[ai][1][m][0], b1 = acc[ai][1][m][1];
                u32x4 w;
                w.x = cvt_pk_bf16(a0[0] * sigmoid_f(b0[0]) * bf_lo(z.x), a0[1] * sigmoid_f(b0[1]) * bf_hi(z.x));
                w.y = cvt_pk_bf16(a0[2] * sigmoid_f(b0[2]) * bf_lo(z.y), a0[3] * sigmoid_f(b0[3]) * bf_hi(z.y));
                w.z = cvt_pk_bf16(a1[0] * sigmoid_f(b1[0]) * bf_lo(z.z), a1[1] * sigmoid_f(b1[1]) * bf_hi(z.z));
                w.w = cvt_pk_bf16(a1[2] * sigmoid_f(b1[2]) * bf_lo(z.w), a1[3] * sigmoid_f(b1[3]) * bf_hi(z.w));
                *(u32x4*)(HS + off) = w; }
    }
};
template <bool ADD> struct EpiGate {
    static constexpr bool PERM = true, AFTER_DRAIN = false;
    const bf16_t* G; bf16_t* O;
    __device__ __forceinline__ void operator()(const f32x4 (&acc)[2][2][4][2], const Unit& u, int wr, int wc, int fr, int fq) const {
        const int row0 = u.pm * BM + wr * 64 + fr, col0 = u.pn * BM + wc * 32 + 8 * fq;
#pragma unroll
        for (int ai = 0; ai < 2; ++ai)
#pragma unroll
            for (int m = 0; m < 4; ++m)
#pragma unroll
                for (int bj = 0; bj < 2; ++bj) { const size_t off = (size_t)(row0 + ai * HALF + m * 16) * 2048 + col0 + bj * HALF;
                    const u32x4 g = *(const u32x4*)(G + off); const f32x4 v0 = acc[ai][bj][m][0], v1 = acc[ai][bj][m][1];
                    float o[8] = {v0[0] * bf_lo(g.x), v0[1] * bf_hi(g.x), v0[2] * bf_lo(g.y), v0[3] * bf_hi(g.y), v1[0] * bf_lo(g.z), v1[1] * bf_hi(g.z), v1[2] * bf_lo(g.w), v1[3] * bf_hi(g.w)};
                    if (ADD) { const u32x4 p = *(const u32x4*)(O + off);
                        o[0] += bf_lo(p.x); o[1] += bf_hi(p.x); o[2] += bf_lo(p.y); o[3] += bf_hi(p.y); o[4] += bf_lo(p.z); o[5] += bf_hi(p.z); o[6] += bf_lo(p.w); o[7] += bf_hi(p.w); }
                    u32x4 w; w.x = cvt_pk_bf16(o[0], o[1]); w.y = cvt_pk_bf16(o[2], o[3]); w.z = cvt_pk_bf16(o[4], o[5]); w.w = cvt_pk_bf16(o[6], o[7]);
                    *(u32x4*)(O + off) = w; }
    }
};
struct EpiResid {
    static constexpr bool PERM = false, AFTER_DRAIN = false;
    const float* X; float* C;
    __device__ __forceinline__ void operator()(const f32x4 (&acc)[2][2][4][2], const Unit& u, int wr, int wc, int fr, int fq) const {
        const int row0 = u.pm * BM + wr * 64 + fr, col0 = u.pn * BM + wc * 32 + 4 * fq;
#pragma unroll
        for (int ai = 0; ai < 2; ++ai)
#pragma unroll
            for (int m = 0; m < 4; ++m) { const size_t ro = (size_t)(row0 + ai * HALF + m * 16) * DM + col0;
#pragma unroll
                for (int bj = 0; bj < 2; ++bj)
#pragma unroll
                    for (int n = 0; n < 2; ++n) { const f32x4 xv = *(const f32x4*)(X + ro + bj * HALF + n * 16); *(f32x4*)(C + ro + bj * HALF + n * 16) = xv * DEEPNORM_ALPHA + acc[ai][bj][m][n]; } }
    }
};

template <class Epi, class Sched, bool ALIGN_EPI = false, bool SP2 = false>
__device__ __forceinline__ void gemm_phase(PG8_LAS unsigned char* lds, const Gemm g, const Sched& S, const Epi& E) {
    const int tid = threadIdx.x, wid = __builtin_amdgcn_readfirstlane(tid >> 6), lane = tid & 63, wr = wid >> 2, wc = wid & 3, fr = lane & 15, fq = lane >> 4;
    const int K = g.K, nt = K / BK;
    unsigned voffA[2], voffB[2];
#pragma unroll
    for (int i = 0; i < 2; ++i) { int R, C; stage_rc(tid * 16 + i * 8192, R, C); const int Rb = Epi::PERM ? ((R & ~31) + perm32(R & 31)) : R;
        voffA[i] = g.amode ? (unsigned)((((C >> 4) * 8192 + R) * 16 + (C & 15)) * 2) : (unsigned)(R * K + C) * 2u;
        voffB[i] = (unsigned)(Rb * K + C) * 2u; }
    const size_t kstepB = (size_t)(BK * 2), hstepB = (size_t)HALF * K * 2, tstepB = 2 * hstepB;
    const size_t kstepA = g.amode ? (size_t)4 * 8192 * 32 : (size_t)(BK * 2), hstepA = g.amode ? (size_t)HALF * 32 : (size_t)HALF * K * 2;
#define PG8_TILEA(pm) (g.amode ? (const char*)g.A + ((size_t)((pm) >> 5) * 64 * 8192 + (size_t)((pm) & 31) * 256) * 32 : (const char*)g.A + (size_t)(pm) * 2 * hstepA)
    const unsigned ldsw = (unsigned)wid * 1024u;
    const int aoff = lds_byte(wr * 64 + fr, fq * 8), boff = lds_byte(wc * 32 + fr, fq * 8);
#define PG8_SA(b, h) (((b) * 2 + (h)) * HTB)
#define PG8_SB(b, h) ((4 + (b) * 2 + (h)) * HTB)
#define PG8_STAGE(bufoff, gbase, voff) do { _Pragma("unroll") for (int _i = 0; _i < 2; ++_i) \
        __builtin_amdgcn_global_load_lds((const unsigned*)((const char*)(gbase) + (voff)[_i]), (PG8_LAS unsigned*)(lds + (bufoff) + ldsw + _i * 8192), 16, 0, 0); } while (0)
#define PG8_LDA(dst, b, h) do { _Pragma("unroll") for (int m = 0; m < 4; ++m) _Pragma("unroll") for (int k = 0; k < 2; ++k) dst[m][k] = *(const PG8_LAS bf16x8*)(lds + PG8_SA(b, h) + aoff + m * 2048 + k * 1024); } while (0)
#define PG8_LDB(dst, b, h) do { _Pragma("unroll") for (int n = 0; n < 2; ++n) _Pragma("unroll") for (int k = 0; k < 2; ++k) dst[n][k] = *(const PG8_LAS bf16x8*)(lds + PG8_SB(b, h) + boff + n * 2048 + k * 1024); } while (0)
#define PG8_MMA(ai, bj, At, Bt) do { __builtin_amdgcn_s_setprio(1); _Pragma("unroll") for (int m = 0; m < 4; ++m) _Pragma("unroll") for (int n = 0; n < 2; ++n) _Pragma("unroll") for (int k = 0; k < 2; ++k) \
        acc[ai][bj][m][n] = __builtin_amdgcn_mfma_f32_16x16x32_bf16(Bt[n][k], At[m][k], acc[ai][bj][m][n], 0, 0, 0); __builtin_amdgcn_s_setprio(0); } while (0)
#define PG8_WAIT_V(n) asm volatile("s_waitcnt vmcnt(" #n ")" ::: "memory")
#define PG8_WAIT_L(n) asm volatile("s_waitcnt lgkmcnt(" #n ")" ::: "memory")
#define PG8_BAR __builtin_amdgcn_s_barrier()
#define PG8_SCHED __builtin_amdgcn_sched_barrier(0)
    Unit cur, nxt; int ui = 0;
    if (!S.next(0, cur)) return;
    f32x4 acc[2][2][4][2];
#pragma unroll
    for (int a = 0; a < 2; ++a)
#pragma unroll
        for (int b = 0; b < 2; ++b)
#pragma unroll
            for (int m = 0; m < 4; ++m)
#pragma unroll
                for (int n = 0; n < 2; ++n) acc[a][b][m][n] = (f32x4){0.f, 0.f, 0.f, 0.f};
    bf16x8 At[4][2], B0[2][2], B1[2][2];
    const char* cA = PG8_TILEA(cur.pm); const char* cB = (const char*)g.Bt + (size_t)cur.pn * tstepB;
    S.a_ready(cur);
    if constexpr (SP2) {
        PG8_STAGE(PG8_SB(0, 0), cB, voffB); PG8_STAGE(PG8_SB(0, 1), cB + hstepB, voffB); PG8_STAGE(PG8_SA(0, 0), cA, voffA); PG8_STAGE(PG8_SA(0, 1), cA + hstepA, voffA);
        if (wr == 1) PG8_BAR;
        PG8_WAIT_V(2); PG8_BAR;
        PG8_STAGE(PG8_SB(1, 0), cB + kstepB, voffB); PG8_STAGE(PG8_SA(1, 0), cA + kstepA, voffA); PG8_STAGE(PG8_SB(1, 1), cB + hstepB + kstepB, voffB);
        PG8_WAIT_V(6); PG8_BAR;
    } else {
        PG8_STAGE(PG8_SB(0, 0), cB, voffB); PG8_STAGE(PG8_SA(0, 0), cA, voffA); PG8_STAGE(PG8_SB(0, 1), cB + hstepB, voffB); PG8_STAGE(PG8_SA(0, 1), cA + hstepA, voffA);
        if (wr == 1) PG8_BAR;
        PG8_WAIT_V(4); PG8_BAR;
        PG8_STAGE(PG8_SB(1, 0), cB + kstepB, voffB); PG8_STAGE(PG8_SA(1, 0), cA + kstepA, voffA); PG8_STAGE(PG8_SB(1, 1), cB + hstepB + kstepB, voffB);
        PG8_WAIT_V(6); PG8_BAR;
    }
    for (;;) {
        const bool has_next = S.next(ui + 1, nxt);
        const char* nA = has_next ? PG8_TILEA(nxt.pm) : cA; const char* nB = has_next ? (const char*)g.Bt + (size_t)nxt.pn * tstepB : cB;
        for (int t = 0; t < nt; t += 2) {
            const bool last = (t == nt - 2);
            const char* a1 = cA + (size_t)(t + 1) * kstepA;
            const char* a2 = last ? nA : cA + (size_t)(t + 2) * kstepA; const char* b2 = last ? nB : cB + (size_t)(t + 2) * kstepB;
            const char* a3 = a2 + kstepA; const char* b3 = b2 + kstepB;
            if (last && has_next) S.a_ready(nxt);
            if constexpr (SP2) {
            PG8_LDB(B0, 0, 0); PG8_LDB(B1, 0, 1); PG8_SCHED; PG8_LDA(At, 0, 0); PG8_STAGE(PG8_SA(1, 1), a1 + hstepA, voffA);
            PG8_WAIT_V(8); PG8_WAIT_L(0); PG8_BAR; PG8_MMA(0, 0, At, B0); PG8_MMA(0, 1, At, B1); PG8_BAR; PG8_SCHED;
            PG8_LDA(At, 0, 1); PG8_STAGE(PG8_SB(0, 0), b2, voffB); PG8_STAGE(PG8_SB(0, 1), b2 + hstepB, voffB); PG8_STAGE(PG8_SA(0, 0), a2, voffA);
            PG8_WAIT_V(8); PG8_WAIT_L(0); PG8_BAR; PG8_MMA(1, 0, At, B0); PG8_MMA(1, 1, At, B1); PG8_BAR; PG8_SCHED;
            PG8_LDB(B0, 1, 0); PG8_LDB(B1, 1, 1); PG8_SCHED; PG8_LDA(At, 1, 0); PG8_STAGE(PG8_SA(0, 1), a2 + hstepA, voffA);
            PG8_WAIT_V(8); PG8_WAIT_L(0); PG8_BAR; PG8_MMA(0, 0, At, B0); PG8_MMA(0, 1, At, B1); PG8_BAR; PG8_SCHED;
            PG8_LDA(At, 1, 1); PG8_STAGE(PG8_SB(1, 0), b3, voffB); PG8_STAGE(PG8_SB(1, 1), b3 + hstepB, voffB); PG8_STAGE(PG8_SA(1, 0), a3, voffA);
            PG8_WAIT_V(8); PG8_WAIT_L(0); PG8_BAR; PG8_MMA(1, 0, At, B0); PG8_MMA(1, 1, At, B1); PG8_BAR; PG8_SCHED;
            } else {
            PG8_LDB(B0, 0, 0); PG8_SCHED; PG8_LDA(At, 0, 0); PG8_STAGE(PG8_SA(1, 1), a1 + hstepA, voffA);
            PG8_WAIT_L(8); PG8_BAR; PG8_WAIT_L(0); PG8_MMA(0, 0, At, B0); PG8_BAR; PG8_SCHED;
            PG8_LDB(B1, 0, 1); PG8_STAGE(PG8_SB(0, 0), b2, voffB);
            PG8_BAR; PG8_WAIT_L(0); PG8_MMA(0, 1, At, B1); PG8_BAR;
            PG8_LDA(At, 0, 1); PG8_STAGE(PG8_SA(0, 0), a2, voffA);
            PG8_BAR; PG8_WAIT_L(0); PG8_MMA(1, 0, At, B0); PG8_BAR; PG8_SCHED;
            PG8_STAGE(PG8_SB(0, 1), b2 + hstepB, voffB);
            PG8_WAIT_V(6); PG8_BAR; PG8_MMA(1, 1, At, B1); PG8_BAR;
            PG8_LDB(B0, 1, 0); PG8_SCHED; PG8_LDA(At, 1, 0); PG8_STAGE(PG8_SA(0, 1), a2 + hstepA, voffA);
            PG8_WAIT_L(8); PG8_BAR; PG8_WAIT_L(0); PG8_MMA(0, 0, At, B0); PG8_BAR; PG8_SCHED;
            PG8_LDB(B1, 1, 1); PG8_STAGE(PG8_SB(1, 0), b3, voffB);
            PG8_BAR; PG8_WAIT_L(0); PG8_MMA(0, 1, At, B1); PG8_BAR;
            PG8_LDA(At, 1, 1); PG8_STAGE(PG8_SA(1, 0), a3, voffA);
            PG8_BAR; PG8_WAIT_L(0); PG8_MMA(1, 0, At, B0); PG8_BAR; PG8_SCHED;
            PG8_STAGE(PG8_SB(1, 1), b3 + hstepB, voffB);
            PG8_WAIT_V(6); PG8_BAR; PG8_MMA(1, 1, At, B1); PG8_BAR;
            }
        }
        if constexpr (ALIGN_EPI) { if (wr == 0) PG8_BAR; }
        if constexpr (!Epi::AFTER_DRAIN) { E(acc, cur, wr, wc, fr, fq); S.done(cur); }
        if (!has_next) break;
#pragma unroll
        for (int a = 0; a < 2; ++a)
#pragma unroll
            for (int b = 0; b < 2; ++b)
#pragma unroll
                for (int m = 0; m < 4; ++m)
#pragma unroll
                    for (int n = 0; n < 2; ++n) acc[a][b][m][n] = (f32x4){0.f, 0.f, 0.f, 0.f};
        cur = nxt; cA = nA; cB = nB; ++ui;
        if constexpr (ALIGN_EPI) { if (wr == 1) PG8_BAR; }
    }
    PG8_WAIT_V(0);
    if constexpr (!ALIGN_EPI) { if (wr == 0) PG8_BAR; }
    PG8_BAR;
#undef PG8_TILEA
#undef PG8_SA
#undef PG8_SB
#undef PG8_STAGE
#undef PG8_LDA
#undef PG8_LDB
#undef PG8_MMA
#undef PG8_WAIT_V
#undef PG8_WAIT_L
#undef PG8_BAR
#undef PG8_SCHED
}
}

constexpr int NWAVES = 8;
constexpr int N_PHASES = 8;
constexpr size_t MiB = 1u << 20;
constexpr size_t WS_CTL = 0;
constexpr size_t WS_BIAS = 64 * 1024;
constexpr size_t WS_WIN = 1 * MiB;
constexpr size_t WS_WGLU = 36 * MiB;
constexpr size_t WS_WBS = 40 * MiB, WS_WBA = 44 * MiB;
constexpr size_t WS_WOUT = 48 * MiB;
constexpr size_t WS_XB = 64 * MiB;
constexpr size_t WS_U = 192 * MiB;
constexpr size_t WS_ZS = 256 * MiB;
constexpr size_t WS_Q = 320 * MiB;
constexpr size_t WS_K = 384 * MiB, WS_V = 400 * MiB;
constexpr size_t WS_ZA = 416 * MiB;
constexpr size_t WS_GS = 480 * MiB, WS_GA = 608 * MiB;
constexpr size_t WS_Y = 736 * MiB;
constexpr size_t WS_HA = 800 * MiB;
constexpr size_t WS_TTAB = 56 * MiB;
constexpr size_t WS_FTAB = 57 * MiB;
constexpr size_t WS_AL = 61 * MiB;
constexpr size_t WS_GTAB = 864 * MiB;
constexpr size_t WS_END = 868 * MiB;

constexpr int RING_BYTES = 131072, LDS_BYTES = 147456;

#define GAS __attribute__((address_space(1)))
#define LAS __attribute__((address_space(3)))
typedef unsigned short bf16;
typedef unsigned v4u __attribute__((ext_vector_type(4)));
typedef float f32x4 __attribute__((ext_vector_type(4)));
#define LDS_WAIT() asm volatile("s_waitcnt lgkmcnt(0)" ::: "memory")
__device__ __forceinline__ unsigned f2bf(float f) { unsigned u = __builtin_bit_cast(unsigned, f); return (u + 0x7fffu + ((u >> 16) & 1u)) >> 16; }
__device__ __forceinline__ unsigned pk2(float lo, float hi) { return f2bf(lo) | (f2bf(hi) << 16); }
__device__ __forceinline__ float bf2f(unsigned short h) { return __uint_as_float(((unsigned)h) << 16); }

__device__ __forceinline__ void p0_transpose_item(const float* W, int K, int N, bf16* WT, int k0, int n0, int wt_row0, LAS float* scr, int lane) {
#pragma unroll 8
    for (int i = 0; i < 32; ++i) { const int kk = 2 * i + (lane >> 5); scr[kk * 33 + (lane & 31)] = W[(size_t)(k0 + kk) * N + n0 + (lane & 31)]; }
    LDS_WAIT(); asm volatile("" ::: "memory");
    const int c = lane & 7;
#pragma unroll
    for (int j = 0; j < 4; ++j) { const int n = (lane >> 3) + 8 * j; const LAS float* s = scr + (8 * c) * 33 + n;
        v4u o; o.x = pk2(s[0 * 33], s[1 * 33]); o.y = pk2(s[2 * 33], s[3 * 33]); o.z = pk2(s[4 * 33], s[5 * 33]); o.w = pk2(s[6 * 33], s[7 * 33]);
        *(GAS v4u*)(WT + (size_t)(wt_row0 + n) * K + k0 + 8 * c) = o; }
    LDS_WAIT(); asm volatile("" ::: "memory");
}

__device__ __forceinline__ int t5_bucket(int dist) {
    if (dist < 16) return dist;
    const float d = (float)dist;
    int large = 16 + (int)(logf(d / 16.0f) / logf(8.0f) * 16.0f);
    return large < 31 ? large : 31;
}

struct Args { const float* in[18]; float* out; unsigned char* ws; int ph_lo, ph_hi; };

__device__ __forceinline__ void ssm_simple_unit(const Args& a, int unit, int lane) {
    const int b = unit >> 6, g = unit & 63, p = lane;
    const float* lam_re = a.in[2]; const float* lam_im = a.in[3]; const float* b_re = a.in[4]; const float* b_im = a.in[5];
    const float* c_re = a.in[6]; const float* c_im = a.in[7]; const float* dsk = a.in[8]; const float* lstep = a.in[9];
    const float step = expf(lstep[g]);
    const float lr = lam_re[g * 64 + p], li = lam_im[g * 64 + p];
    const float mag = expf(lr * step); float sn, cs; sincosf(li * step, &sn, &cs);
    const float ar = mag * cs, ai = mag * sn;
    const float nr = ar - 1.0f, ni = ai, den = lr * lr + li * li;
    const float fr = (nr * lr + ni * li) / den, fi = (ni * lr - nr * li) / den;
    float bbr[16], bbi[16], cr[16], ci[16], dd[16];
#pragma unroll
    for (int h = 0; h < 16; ++h) { const float br = b_re[(g * 64 + p) * 16 + h], bi = b_im[(g * 64 + p) * 16 + h];
        bbr[h] = fr * br - fi * bi; bbi[h] = fr * bi + fi * br;
        cr[h] = c_re[(g * 16 + h) * 64 + p]; ci[h] = c_im[(g * 16 + h) * 64 + p]; dd[h] = dsk[g * 16 + h]; }
    const bf16* U = (const bf16*)(a.ws + WS_U) + (size_t)(b * 64 + g) * 8192 * 16;
    bf16* Y = (bf16*)(a.ws + WS_Y) + (size_t)(b * 64 + g) * 8192 * 16;
    const int hown = 8 * (lane & 1) + 4 * ((lane >> 1) & 1) + 2 * ((lane >> 2) & 1) + ((lane >> 3) & 1);
    float sr = 0.f, si = 0.f;
    for (int t = 0; t < 8192; ++t) {
        const v4u u0 = *(const v4u*)(U + (size_t)t * 16), u1 = *(const v4u*)(U + (size_t)t * 16 + 8);
        float u[16] = {pg8::bf_lo(u0.x), pg8::bf_hi(u0.x), pg8::bf_lo(u0.y), pg8::bf_hi(u0.y), pg8::bf_lo(u0.z), pg8::bf_hi(u0.z), pg8::bf_lo(u0.w), pg8::bf_hi(u0.w),
                       pg8::bf_lo(u1.x), pg8::bf_hi(u1.x), pg8::bf_lo(u1.y), pg8::bf_hi(u1.y), pg8::bf_lo(u1.z), pg8::bf_hi(u1.z), pg8::bf_lo(u1.w), pg8::bf_hi(u1.w)};
        float bur = 0.f, bui = 0.f;
#pragma unroll
        for (int h = 0; h < 16; ++h) { bur += bbr[h] * u[h]; bui += bbi[h] * u[h]; }
        const float nsr = ar * sr - ai * si + bur, nsi = ar * si + ai * sr + bui; sr = nsr; si = nsi;
        float z[16];
#pragma unroll
        for (int h = 0; h < 16; ++h) z[h] = cr[h] * sr - ci[h] * si;
#pragma unroll
        for (int i = 0; i < 8; ++i) { const bool up = (lane & 1) != 0; const float send = up ? z[i] : z[i + 8], keep = up ? z[i + 8] : z[i]; z[i] = keep + __shfl_xor(send, 1); }
#pragma unroll
        for (int i = 0; i < 4; ++i) { const bool up = (lane & 2) != 0; const float send = up ? z[i] : z[i + 4], keep = up ? z[i + 4] : z[i]; z[i] = keep + __shfl_xor(send, 2); }
#pragma unroll
        for (int i = 0; i < 2; ++i) { const bool up = (lane & 4) != 0; const float send = up ? z[i] : z[i + 2], keep = up ? z[i + 2] : z[i]; z[i] = keep + __shfl_xor(send, 4); }
        { const bool up = (lane & 8) != 0; const float send = up ? z[0] : z[1], keep = up ? z[1] : z[0]; z[0] = keep + __shfl_xor(send, 8); }
        float tot = z[0]; tot += __shfl_xor(tot, 16); tot += __shfl_xor(tot, 32);
        float uo = 0.f, dv = 0.f;
#pragma unroll
        for (int h = 0; h < 16; ++h) { if (h == hown) { uo = u[h]; dv = dd[h]; } }
        const float y = tot + dv * uo;
        if (lane < 16) Y[(size_t)t * 16 + hown] = (bf16)f2bf(pg8::gelu_f(y));
    }
}

__device__ __forceinline__ void attn_simple_item(const Args& a, int item) {
    const int row = item >> 4, h = item & 15, kvh = h >> 2, t = row & 8191;
    const bf16* Q = (const bf16*)(a.ws + WS_Q); const bf16* Kb = (const bf16*)(a.ws + WS_K); const bf16* Vb = (const bf16*)(a.ws + WS_V);
    const bf16* ZA = (const bf16*)(a.ws + WS_ZA); bf16* HA = (bf16*)(a.ws + WS_HA);
    const float* biasd = (const float*)(a.ws + WS_BIAS) + h * 128;
    float q[64], o[64];
#pragma unroll
    for (int c = 0; c < 8; ++c) { const v4u w = *(const v4u*)(Q + (size_t)row * 1024 + h * 64 + c * 8);
        q[c * 8 + 0] = pg8::bf_lo(w.x); q[c * 8 + 1] = pg8::bf_hi(w.x); q[c * 8 + 2] = pg8::bf_lo(w.y); q[c * 8 + 3] = pg8::bf_hi(w.y);
        q[c * 8 + 4] = pg8::bf_lo(w.z); q[c * 8 + 5] = pg8::bf_hi(w.z); q[c * 8 + 6] = pg8::bf_lo(w.w); q[c * 8 + 7] = pg8::bf_hi(w.w); }
#pragma unroll
    for (int d = 0; d < 64; ++d) o[d] = 0.f;
    float mx = a.in[11][h] * LOG2E, l = 1.0f;
    const int nd = t < 127 ? t : 127;
    for (int dist = 0; dist <= nd; ++dist) {
        const size_t kr = (size_t)(row - dist) * 256 + kvh * 64;
        float s = 0.f;
#pragma unroll
        for (int c = 0; c < 8; ++c) { const v4u w = *(const v4u*)(Kb + kr + c * 8);
            s += q[c * 8 + 0] * pg8::bf_lo(w.x) + q[c * 8 + 1] * pg8::bf_hi(w.x) + q[c * 8 + 2] * pg8::bf_lo(w.y) + q[c * 8 + 3] * pg8::bf_hi(w.y)
               + q[c * 8 + 4] * pg8::bf_lo(w.z) + q[c * 8 + 5] * pg8::bf_hi(w.z) + q[c * 8 + 6] * pg8::bf_lo(w.w) + q[c * 8 + 7] * pg8::bf_hi(w.w); }
        s += biasd[dist];
        const float mn = fmaxf(mx, s), sc = exp2f(mx - mn), pr = exp2f(s - mn);
        l = l * sc + pr; mx = mn;
#pragma unroll
        for (int c = 0; c < 8; ++c) { const v4u w = *(const v4u*)(Vb + kr + c * 8);
            o[c * 8 + 0] = o[c * 8 + 0] * sc + pr * pg8::bf_lo(w.x); o[c * 8 + 1] = o[c * 8 + 1] * sc + pr * pg8::bf_hi(w.x);
            o[c * 8 + 2] = o[c * 8 + 2] * sc + pr * pg8::bf_lo(w.y); o[c * 8 + 3] = o[c * 8 + 3] * sc + pr * pg8::bf_hi(w.y);
            o[c * 8 + 4] = o[c * 8 + 4] * sc + pr * pg8::bf_lo(w.z); o[c * 8 + 5] = o[c * 8 + 5] * sc + pr * pg8::bf_hi(w.z);
            o[c * 8 + 6] = o[c * 8 + 6] * sc + pr * pg8::bf_lo(w.w); o[c * 8 + 7] = o[c * 8 + 7] * sc + pr * pg8::bf_hi(w.w); }
    }
    const float rl = 1.0f / l;
#pragma unroll
    for (int c = 0; c < 8; ++c) { const size_t off = (size_t)row * 1024 + h * 64 + c * 8; const v4u z = *(const v4u*)(ZA + off);
        v4u w; w.x = pk2(o[c * 8 + 0] * rl * pg8::bf_lo(z.x), o[c * 8 + 1] * rl * pg8::bf_hi(z.x)); w.y = pk2(o[c * 8 + 2] * rl * pg8::bf_lo(z.y), o[c * 8 + 3] * rl * pg8::bf_hi(z.y));
        w.z = pk2(o[c * 8 + 4] * rl * pg8::bf_lo(z.z), o[c * 8 + 5] * rl * pg8::bf_hi(z.z)); w.w = pk2(o[c * 8 + 6] * rl * pg8::bf_lo(z.w), o[c * 8 + 7] * rl * pg8::bf_hi(z.w));
        *(v4u*)(HA + off) = w; }
}


#ifndef SIMPLE_SSM
#define SIMPLE_SSM 0
#endif
#ifndef SIMPLE_ATTN
#define SIMPLE_ATTN 0
#endif
typedef short bf16x8_t __attribute__((ext_vector_type(8)));
typedef float f32x16 __attribute__((ext_vector_type(16)));
typedef short v4i16_t __attribute__((ext_vector_type(4)));
typedef unsigned v2u __attribute__((ext_vector_type(2)));
typedef float f32x2v __attribute__((ext_vector_type(2)));

__device__ __forceinline__ void ssm_tables(const Args& a, LAS unsigned char* L, int tg, int tid) {
    const int g = tg & 63, quarter = tg >> 6;
    LAS f32x2v* pw = (LAS f32x2v*)L;
    LAS f32x2v* bb = (LAS f32x2v*)(L + 8704);
    LAS f32x2v* cc = (LAS f32x2v*)(L + 8704 + 8192);
    const float* lam_re = a.in[2]; const float* lam_im = a.in[3]; const float* b_re = a.in[4]; const float* b_im = a.in[5];
    const float* c_re = a.in[6]; const float* c_im = a.in[7];
    const float step = expf(a.in[9][g]);
    for (int idx = tid; idx < 17 * 64; idx += 512) { const int d = idx >> 6, p = idx & 63; const float lr = lam_re[g * 64 + p], li = lam_im[g * 64 + p];
        const float mag = expf(lr * step * (float)d); float sn, cs; sincosf(li * step * (float)d, &sn, &cs); pw[idx] = (f32x2v){mag * cs, mag * sn}; }
    for (int idx = tid; idx < 1024; idx += 512) { const int p = idx >> 4, h = idx & 15; const float lr = lam_re[g * 64 + p], li = lam_im[g * 64 + p];
        const float mag = expf(lr * step); float sn, cs; sincosf(li * step, &sn, &cs);
        const float nr = mag * cs - 1.0f, ni = mag * sn, den = lr * lr + li * li, fr = (nr * lr + ni * li) / den, fi = (ni * lr - nr * li) / den;
        const float br = b_re[(g * 64 + p) * 16 + h], bi = b_im[(g * 64 + p) * 16 + h]; bb[idx] = (f32x2v){fr * br - fi * bi, fr * bi + fi * br}; }
    for (int idx = tid; idx < 1024; idx += 512) { const int h = idx >> 6, p = idx & 63; cc[idx] = (f32x2v){c_re[(g * 16 + h) * 64 + p], c_im[(g * 16 + h) * 64 + p]}; }
    __syncthreads();
    for (int k = 0; k < 5; ++k) { const int q = quarter * 512 + tid + 2048 * k; if (q >= 9216) break;
        const int l = q & 63, r = l & 31, hh = l >> 5; float v[8]; bf16* dst;
        if (q < 1024) { const int dd = (q >> 6) - 1 + (r >> 4), h = r & 15;
#pragma unroll
            for (int jj = 0; jj < 8; ++jj) v[jj] = 0.f;
            if (dd >= 0) for (int p = 0; p < 64; ++p) { const f32x2v c = cc[h * 64 + p], w = pw[dd * 64 + p]; const float ar = c.x * w.x - c.y * w.y, ai = c.x * w.y + c.y * w.x;
#pragma unroll
                for (int jj = 0; jj < 8; ++jj) { const f32x2v bq = bb[p * 16 + 8 * hh + jj]; v[jj] += ar * bq.x - ai * bq.y; } }
            dst = (bf16*)(a.ws + WS_TTAB) + ((size_t)g * 1024 + q) * 8;
        } else if (q < 5120) { const int q2 = q - 1024, pb = q2 >> 10, j = (q2 >> 6) & 15, p2 = 32 * pb + r, p = p2 & 63; const f32x2v w = pw[(15 - j) * 64 + p];
#pragma unroll
            for (int jj = 0; jj < 8; ++jj) { const f32x2v bq = bb[p * 16 + 8 * hh + jj]; v[jj] = p2 < 64 ? (w.x * bq.x - w.y * bq.y) : (w.x * bq.y + w.y * bq.x); }
            dst = (bf16*)(a.ws + WS_FTAB) + ((size_t)g * 4096 + q2) * 8;
        } else { const int q3 = q - 5120, rb = q3 >> 9, kk = (q3 >> 6) & 7, R = 32 * rb + r, t = R >> 4, h = R & 15;
#pragma unroll
            for (int jj = 0; jj < 8; ++jj) { const int p2 = 16 * kk + 8 * hh + jj, p = p2 & 63; const f32x2v c = cc[h * 64 + p], w = pw[(t + 1) * 64 + p];
                v[jj] = p2 < 64 ? (c.x * w.x - c.y * w.y) : -(c.x * w.y + c.y * w.x); }
            dst = (bf16*)(a.ws + WS_GTAB) + ((size_t)g * 4096 + q3) * 8;
        }
        v4u o; o.x = pk2(v[0], v[1]); o.y = pk2(v[2], v[3]); o.z = pk2(v[4], v[5]); o.w = pk2(v[6], v[7]); *(v4u*)dst = o;
    }
    if (quarter == 0 && tid < 64) ((f32x2v*)(a.ws + WS_AL))[g * 64 + tid] = pw[16 * 64 + tid];
    __syncthreads();
}

__device__ __forceinline__ void ssm_unit(const Args& a, LAS unsigned char* L, int unit, int tid, int lane, int wave) {
    const int b = unit >> 6, g = unit & 63, n = lane & 31, hh = lane >> 5;
    unsigned char* ws = a.ws;
    constexpr int TT = 0, UB0 = 16384, UBS = 32 * 528, EP = UB0 + 2 * UBS, SI = EP + 2 * 32 * 129 * 4, SIS = 272;
    static_assert(SI + 32 * SIS <= RING_BYTES, "ssm LDS map");
    const bf16* Ug = (const bf16*)(ws + WS_U) + (size_t)(b * 64 + g) * 8192 * 16;
    bf16* Yg = (bf16*)(ws + WS_Y) + (size_t)(b * 64 + g) * 8192 * 16;
    { const v4u* src = (const v4u*)(ws + WS_TTAB) + g * 1024;
#pragma unroll
      for (int i = 0; i < 2; ++i) ((LAS v4u*)(L + TT))[tid + 512 * i] = src[tid + 512 * i]; }
    bf16x8_t Ffr[8], Gfr[8];
    { const bf16x8_t* fs = (const bf16x8_t*)(ws + WS_FTAB) + ((size_t)g * 4096 + ((wave & 3) * 16 + (wave >> 2) * 8) * 64 + lane);
#pragma unroll
      for (int i = 0; i < 8; ++i) Ffr[i] = fs[i * 64];
      const bf16x8_t* gs = (const bf16x8_t*)(ws + WS_GTAB) + ((size_t)g * 4096 + (wave * 8) * 64 + lane);
#pragma unroll
      for (int kk = 0; kk < 8; ++kk) Gfr[kk] = gs[kk * 64]; }
    const f32x2v aL = ((const f32x2v*)(ws + WS_AL))[g * 64 + lane];
    float dlo[4], dhi[4];
#pragma unroll
    for (int i = 0; i < 4; ++i) { dlo[i] = a.in[8][g * 16 + 4 * hh + i]; dhi[i] = a.in[8][g * 16 + 8 + 4 * hh + i]; }
    v4u pre[2];
#pragma unroll
    for (int i = 0; i < 2; ++i) { const int q = tid + 512 * i; pre[i] = *(const v4u*)(Ug + (size_t)q * 8); }
#pragma unroll
    for (int i = 0; i < 2; ++i) { const int q = tid + 512 * i; *(LAS v4u*)(L + UB0 + (q >> 5) * 528 + (q & 31) * 16) = pre[i]; }
    __syncthreads();
    float sr = 0.f, si = 0.f;
    const int kh = wave >> 2, pb = wave & 3;
    for (int cb = 0; cb < 16; ++cb) {
        const int ub = UB0 + (cb & 1) * UBS, ubn = UB0 + ((cb & 1) ^ 1) * UBS;
        if (cb + 1 < 16) {
#pragma unroll
            for (int i = 0; i < 2; ++i) pre[i] = *(const v4u*)(Ug + (size_t)(cb + 1) * 8192 + (size_t)(tid + 512 * i) * 8); }
        f32x16 acc;
#pragma unroll
        for (int i = 0; i < 16; ++i) acc[i] = 0.f;
#pragma unroll
        for (int i = 0; i < 8; ++i) { const bf16x8_t Bf = *(const LAS bf16x8_t*)(L + ub + n * 528 + (8 * kh + i) * 32 + hh * 16); acc = __builtin_amdgcn_mfma_f32_32x32x16_bf16(Ffr[i], Bf, acc, 0, 0, 0); }
        { LAS float* ep = (LAS float*)(L + EP) + (kh * 32 + n) * 129 + 32 * pb + 4 * hh;
#pragma unroll
          for (int i = 0; i < 16; ++i) ep[(i & 3) + 8 * (i >> 2)] = acc[i]; }
        __syncthreads();
        if (wave == 0) {
            const LAS float* ep = (const LAS float*)(L + EP); LAS bf16* sip = (LAS bf16*)(L + SI);
#pragma unroll 8
            for (int c = 0; c < 32; ++c) {
                const float er = ep[c * 129 + lane] + ep[(32 + c) * 129 + lane], ei = ep[c * 129 + 64 + lane] + ep[(32 + c) * 129 + 64 + lane];
                sip[c * 136 + lane] = (bf16)f2bf(sr); sip[c * 136 + 64 + lane] = (bf16)f2bf(si);
                const float nr = aL.x * sr - aL.y * si + er, ni = aL.x * si + aL.y * sr + ei; sr = nr; si = ni; }
        }
#pragma unroll
        for (int i = 0; i < 16; ++i) acc[i] = 0.f;
        for (int j = 0; j < 2 * wave + 2; ++j) { const bf16x8_t Tf = *(const LAS bf16x8_t*)(L + TT + (2 * wave - j + 1) * 1024 + lane * 16);
            const bf16x8_t Bf = *(const LAS bf16x8_t*)(L + ub + n * 528 + j * 32 + hh * 16); acc = __builtin_amdgcn_mfma_f32_32x32x16_bf16(Tf, Bf, acc, 0, 0, 0); }
        if (cb + 1 < 16) {
#pragma unroll
            for (int i = 0; i < 2; ++i) { const int q = tid + 512 * i; *(LAS v4u*)(L + ubn + (q >> 5) * 528 + (q & 31) * 16) = pre[i]; } }
        __syncthreads();
#pragma unroll
        for (int kk = 0; kk < 8; ++kk) { const bf16x8_t Sf = *(const LAS bf16x8_t*)(L + SI + n * SIS + (16 * kk + 8 * hh) * 2); acc = __builtin_amdgcn_mfma_f32_32x32x16_bf16(Gfr[kk], Sf, acc, 0, 0, 0); }
#pragma unroll
        for (int q4 = 0; q4 < 4; ++q4) { const int t = 2 * wave + (q4 >> 1), hb = 8 * (q4 & 1) + 4 * hh;
            const v2u uu = *(const LAS v2u*)(L + ub + n * 528 + t * 32 + hb * 2);
            const float u0 = pg8::bf_lo(uu.x), u1 = pg8::bf_hi(uu.x), u2 = pg8::bf_lo(uu.y), u3 = pg8::bf_hi(uu.y);
            const float d0 = (q4 & 1) ? dhi[0] : dlo[0], d1 = (q4 & 1) ? dhi[1] : dlo[1], d2 = (q4 & 1) ? dhi[2] : dlo[2], d3 = (q4 & 1) ? dhi[3] : dlo[3];
            v2u o; o.x = pg8::cvt_pk_bf16(pg8::gelu_f(acc[4 * q4 + 0] + d0 * u0), pg8::gelu_f(acc[4 * q4 + 1] + d1 * u1));
            o.y = pg8::cvt_pk_bf16(pg8::gelu_f(acc[4 * q4 + 2] + d2 * u2), pg8::gelu_f(acc[4 * q4 + 3] + d3 * u3));
            *(v2u*)(Yg + ((size_t)(cb * 512 + n * 16 + t)) * 16 + hb) = o; }
    }
    __syncthreads();
}

__device__ __forceinline__ v4i16_t vtr16(unsigned addr) { return __builtin_amdgcn_ds_read_tr16_b64_v4i16((LAS v4i16_t*)(uintptr_t)addr); }
__device__ __forceinline__ void attn_unit(const Args& a, LAS unsigned char* L, int unit, int tid, int lane, int wave) {
    const int kvh = unit & 3, nb = (unit >> 2) & 63, b = unit >> 8;
    constexpr int KL = 0, VL = 32768, BT = 65536;
    unsigned char* ws = a.ws;
    const bf16* Q = (const bf16*)(ws + WS_Q); const bf16* Kb = (const bf16*)(ws + WS_K); const bf16* Vb = (const bf16*)(ws + WS_V);
    const bf16* ZA = (const bf16*)(ws + WS_ZA); bf16* HA = (bf16*)(ws + WS_HA);
    const size_t row0 = (size_t)b * 8192 + (size_t)nb * 128;
#pragma unroll
    for (int i = 0; i < 4; ++i) { const int q = tid + 512 * i, key = q >> 3, c = q & 7; const bool valid = (nb > 0) || (key >= 128);
        v4u kv = (v4u){0u, 0u, 0u, 0u}, vv = (v4u){0u, 0u, 0u, 0u};
        if (valid) { const size_t off = (row0 + key - 128) * 256 + kvh * 64 + 8 * c; kv = *(const v4u*)(Kb + off); vv = *(const v4u*)(Vb + off); }
        *(LAS v4u*)(L + KL + key * 128 + ((c ^ ((key >> 1) & 7)) << 4)) = kv;
        *(LAS v4u*)(L + VL + key * 128 + ((c * 16) ^ (((key >> 1) & 1) << 6))) = vv; }
    for (int idx = tid; idx < 4 * 192; idx += 512) { const int hl = idx / 192, e = idx - hl * 192, dist = e - 32;
        ((LAS float*)(L + BT))[idx] = (dist >= 0 && dist < 128) ? ((const float*)(ws + WS_BIAS))[(kvh * 4 + hl) * 128 + dist] : -1e30f; }
    __syncthreads();
    const int hl = wave >> 1, hq = kvh * 4 + hl, ql = lane & 31, hh = lane >> 5;
    const float sink2 = a.in[11][hq] * LOG2E;
    const LAS float* bt = (const LAS float*)(L + BT) + hl * 192;
    const unsigned vbase = (unsigned)(uintptr_t)(L + VL);
    for (int qi = 0; qi < 2; ++qi) {
        const int qt = 2 * (wave & 1) + qi;
        const size_t qrow = row0 + 32 * qt + ql;
        bf16x8_t qf[4];
#pragma unroll
        for (int ks = 0; ks < 4; ++ks) qf[ks] = *(const bf16x8_t*)(Q + qrow * 1024 + hq * 64 + 16 * ks + 8 * hh);
        f32x16 s[5];
#pragma unroll
        for (int t5 = 0; t5 < 5; ++t5) { const int kt = qt + t5;
            if (nb == 0 && kt < 4) {
#pragma unroll
                for (int i = 0; i < 16; ++i) s[t5][i] = -1e30f;
            } else {
#pragma unroll
                for (int i = 0; i < 16; ++i) { const int keyl = (i & 3) + 8 * (i >> 2) + 4 * hh; s[t5][i] = bt[160 - 32 * t5 + ql - keyl]; }
                const int key = 32 * kt + ql;
#pragma unroll
                for (int ks = 0; ks < 4; ++ks) { const bf16x8_t Kf = *(const LAS bf16x8_t*)(L + KL + key * 128 + (((2 * ks + hh) ^ ((key >> 1) & 7)) << 4));
                    s[t5] = __builtin_amdgcn_mfma_f32_32x32x16_bf16(Kf, qf[ks], s[t5], 0, 0, 0); }
            } }
        float mx = s[0][0];
#pragma unroll
        for (int t5 = 0; t5 < 5; ++t5)
#pragma unroll
            for (int i = 0; i < 16; ++i) mx = fmaxf(mx, s[t5][i]);
        mx = fmaxf(mx, __shfl_xor(mx, 32)); mx = fmaxf(mx, sink2);
        float ls = 0.f;
#pragma unroll
        for (int t5 = 0; t5 < 5; ++t5)
#pragma unroll
            for (int i = 0; i < 16; ++i) { const float p = __builtin_amdgcn_exp2f(s[t5][i] - mx); s[t5][i] = p; ls += p; }
        ls += __shfl_xor(ls, 32); ls += __builtin_amdgcn_exp2f(sink2 - mx);
        f32x16 o[2];
#pragma unroll
        for (int i = 0; i < 16; ++i) { o[0][i] = 0.f; o[1][i] = 0.f; }
        const int gi = lane >> 4, i_ = lane & 15;
#pragma unroll
        for (int t5 = 0; t5 < 5; ++t5)
#pragma unroll
            for (int sst = 0; sst < 2; ++sst) { const int kt = qt + t5;
                pg8::u32x4 pw4; pw4.x = pg8::cvt_pk_bf16(s[t5][8 * sst + 0], s[t5][8 * sst + 1]); pw4.y = pg8::cvt_pk_bf16(s[t5][8 * sst + 2], s[t5][8 * sst + 3]);
                pw4.z = pg8::cvt_pk_bf16(s[t5][8 * sst + 4], s[t5][8 * sst + 5]); pw4.w = pg8::cvt_pk_bf16(s[t5][8 * sst + 6], s[t5][8 * sst + 7]);
                const bf16x8_t Pf = __builtin_bit_cast(bf16x8_t, pw4);
                const int key = 32 * kt + 16 * sst + 4 * hh + (i_ >> 2);
                const unsigned rowa = vbase + key * 128, sw = ((key >> 1) & 1) << 6;
#pragma unroll
                for (int db = 0; db < 2; ++db) { const unsigned cb_ = (unsigned)(64 * db + 32 * (gi & 1) + 8 * (i_ & 3));
                    const v4i16_t lo = vtr16(rowa + (cb_ ^ sw)), hi = vtr16(rowa + 8 * 128 + (cb_ ^ sw));
                    const bf16x8_t Vf = (bf16x8_t){lo[0], lo[1], lo[2], lo[3], hi[0], hi[1], hi[2], hi[3]};
                    o[db] = __builtin_amdgcn_mfma_f32_32x32x16_bf16(Vf, Pf, o[db], 0, 0, 0); } }
        const float rl = 1.0f / ls;
#pragma unroll
        for (int db = 0; db < 2; ++db)
#pragma unroll
            for (int g4 = 0; g4 < 4; ++g4) { const size_t off = qrow * 1024 + hq * 64 + 32 * db + 8 * g4 + 4 * hh; const v2u z = *(const v2u*)(ZA + off);
                v2u w; w.x = pg8::cvt_pk_bf16(o[db][4 * g4 + 0] * rl * pg8::bf_lo(z.x), o[db][4 * g4 + 1] * rl * pg8::bf_hi(z.x));
                w.y = pg8::cvt_pk_bf16(o[db][4 * g4 + 2] * rl * pg8::bf_lo(z.y), o[db][4 * g4 + 3] * rl * pg8::bf_hi(z.y)); *(v2u*)(HA + off) = w; }
    }
    __syncthreads();
}

__device__ __forceinline__ float wave_sum(float v) {
#pragma unroll
    for (int o = 1; o < 64; o <<= 1) v += __shfl_xor(v, o);
    return v;
}

__global__ void __launch_bounds__(NWAVES * 64, 2) fwd_megakernel(Args args) {
    extern __shared__ __attribute__((aligned(16))) unsigned char lds[];
    cg::grid_group grid = cg::this_grid();
    const int tid = threadIdx.x, lane = tid & 63, wave = __builtin_amdgcn_readfirstlane(tid >> 6);
    const int G = gridDim.x, bx = blockIdx.x;
    const int vcu = (G % 8 == 0) ? (bx % 8) * (G / 8) + bx / 8 : bx;
    unsigned char* ws = args.ws;
    const int lo = args.ph_lo, hi = args.ph_hi;
#define IN(k) (lo <= (k) && (k) < hi)
#define SEAM(k) do { if (IN(k) && IN((k) + 1)) grid.sync(); } while (0)
    LAS unsigned char* ldsl = (LAS unsigned char*)lds;
    const int gw = vcu * NWAVES + wave, NGW = G * NWAVES;
    const int gt = vcu * (NWAVES * 64) + tid, NGT = G * NWAVES * 64;

    if (IN(0)) {
        { const float* x = args.in[0]; bf16* xb = (bf16*)(ws + WS_XB);
          for (size_t i = (size_t)gt; i < (size_t)M * DM / 8; i += NGT) { const f32x4 a = *(const f32x4*)(x + i * 8), b = *(const f32x4*)(x + i * 8 + 4);
              v4u o; o.x = pk2(a[0], a[1]); o.y = pk2(a[2], a[3]); o.z = pk2(b[0], b[1]); o.w = pk2(b[2], b[3]); *(v4u*)(xb + i * 8) = o; } }
        { LAS float* scr = (LAS float*)(ldsl + wave * 16384);
          constexpr int I_IN = (DM / 64) * (D_IN / 32), I_GLU = (D_SSM / 64) * (2048 / 32), I_BS = I_GLU, I_BA = I_GLU, I_OUT = (DM / 64) * (DM / 32);
          constexpr int NITEMS = I_IN + I_GLU + I_BS + I_BA + I_OUT;
          for (int it = gw; it < NITEMS; it += NGW) {
              int r = it;
              if (r < I_IN) { const int nblk = D_IN / 32, kb = r / nblk, nb = r % nblk; p0_transpose_item(args.in[1], DM, D_IN, (bf16*)(ws + WS_WIN), 64 * kb, 32 * nb, 32 * nb, scr, lane); continue; } r -= I_IN;
              if (r < I_GLU) { const int nblk = 2048 / 32, kb = r / nblk, nb = r % nblk, n0 = 32 * nb;
                  const int wrow = 256 * ((n0 & 1023) >> 7) + 128 * (n0 >> 10) + (n0 & 127);
                  p0_transpose_item(args.in[10], D_SSM, 2048, (bf16*)(ws + WS_WGLU), 64 * kb, n0, wrow, scr, lane); continue; } r -= I_GLU;
              if (r < I_BS) { const int nblk = 2048 / 32, kb = r / nblk, nb = r % nblk; p0_transpose_item(args.in[13], D_SSM, DM, (bf16*)(ws + WS_WBS), 64 * kb, 32 * nb, 32 * nb, scr, lane); continue; } r -= I_BS;
              if (r < I_BA) { const int nblk = 2048 / 32, kb = r / nblk, nb = r % nblk; p0_transpose_item(args.in[14], D_ATTN, DM, (bf16*)(ws + WS_WBA), 64 * kb, 32 * nb, 32 * nb, scr, lane); continue; } r -= I_BA;
              { const int nblk = DM / 32, kb = r / nblk, nb = r % nblk; p0_transpose_item(args.in[15], DM, DM, (bf16*)(ws + WS_WOUT), 64 * kb, 32 * nb, 32 * nb, scr, lane); }
          } }
        if (gt < 16 * 128) { const int h = gt >> 7, dist = gt & 127; ((float*)(ws + WS_BIAS))[gt] = args.in[12][t5_bucket(dist) * 16 + h] * LOG2E; }
        __syncthreads();
#if !SIMPLE_SSM
        for (int tg = vcu; tg < 256; tg += G) ssm_tables(args, ldsl, tg, tid);
#endif
    }
    SEAM(0);

    if (IN(1)) {
        pg8::Gemm g{(const bf16*)(ws + WS_XB), (const bf16*)(ws + WS_WIN), DM, 0}; pg8::StaticOrder S; S.init(M, D_IN, G, bx);
        pg8::EpiInProj E{(bf16*)(ws + WS_U), (bf16*)(ws + WS_ZS), (bf16*)(ws + WS_Q), (bf16*)(ws + WS_K), (bf16*)(ws + WS_V), (bf16*)(ws + WS_ZA), (bf16*)(ws + WS_GS), (bf16*)(ws + WS_GA)};
        pg8::gemm_phase<pg8::EpiInProj, pg8::StaticOrder, true, true>(ldsl, g, S, E);
    }
    SEAM(1);

    if (IN(2)) {
#if SIMPLE_SSM
        if (wave == 0) { for (int unit = vcu; unit < BATCH * NG; unit += G) ssm_simple_unit(args, unit, lane); }
#else
        for (int unit = vcu; unit < BATCH * NG; unit += G) ssm_unit(args, ldsl, unit, tid, lane, wave);
#endif
#if SIMPLE_ATTN
        { const int at = vcu * 512 + tid, NAT = G * 512; for (int item = at; item < M * NQH; item += NAT) attn_simple_item(args, item); }
#else
        for (int unit = vcu; unit < BATCH * 64 * NKVH; unit += G) attn_unit(args, ldsl, unit, tid, lane, wave);
#endif
        __syncthreads();
    }
    SEAM(2);

    if (IN(3)) {
        pg8::Gemm g{(const bf16*)(ws + WS_Y), (const bf16*)(ws + WS_WGLU), D_SSM, 1}; pg8::StaticOrder S; S.init(M, 2048, G, bx);
        pg8::EpiGlu E{(const bf16*)(ws + WS_ZS), (bf16*)(ws + WS_Q)};
        pg8::gemm_phase<pg8::EpiGlu, pg8::StaticOrder, true, true>(ldsl, g, S, E);
    }
    SEAM(3);

    if (IN(4)) {
        pg8::Gemm g{(const bf16*)(ws + WS_Q), (const bf16*)(ws + WS_WBS), D_SSM, 0}; pg8::StaticOrder S; S.init(M, DM, G, bx);
        pg8::EpiGate<false> E{(const bf16*)(ws + WS_GS), (bf16*)(ws + WS_XB)};
        pg8::gemm_phase<pg8::EpiGate<false>, pg8::StaticOrder, true, true>(ldsl, g, S, E);
    }
    SEAM(4);

    if (IN(5)) {
        pg8::Gemm g{(const bf16*)(ws + WS_HA), (const bf16*)(ws + WS_WBA), D_ATTN, 0}; pg8::StaticOrder S; S.init(M, DM, G, bx);
        pg8::EpiGate<true> E{(const bf16*)(ws + WS_GA), (bf16*)(ws + WS_XB)};
        pg8::gemm_phase<pg8::EpiGate<true>, pg8::StaticOrder, true, true>(ldsl, g, S, E);
    }
    SEAM(5);

    if (IN(6)) {
        pg8::Gemm g{(const bf16*)(ws + WS_XB), (const bf16*)(ws + WS_WOUT), DM, 0}; pg8::StaticOrder S; S.init(M, DM, G, bx);
        pg8::EpiResid E{args.in[0], args.out};
        pg8::gemm_phase<pg8::EpiResid, pg8::StaticOrder, true, true>(ldsl, g, S, E);
    }
    SEAM(6);

    if (IN(7)) {
        const float* gain = args.in[16]; const float* bias = args.in[17];
        for (int m = gw; m < M; m += NGW) {
            GAS f32x4* xr = (GAS f32x4*)(args.out + (size_t)m * DM) + lane;
            f32x4 v[8]; float s = 0.f;
#pragma unroll
            for (int j = 0; j < 8; ++j) { v[j] = xr[64 * j]; s += (v[j].x + v[j].y) + (v[j].z + v[j].w); }
            const float mean = wave_sum(s) * (1.f / DM); float s2 = 0.f;
#pragma unroll
            for (int j = 0; j < 8; ++j) { v[j] = v[j] - mean; s2 += (v[j].x * v[j].x + v[j].y * v[j].y) + (v[j].z * v[j].z + v[j].w * v[j].w); }
            const float rstd = 1.f / sqrtf(wave_sum(s2) * (1.f / DM) + LN_EPS);
#pragma unroll
            for (int j = 0; j < 8; ++j) { const f32x4 gn = *(const f32x4*)(gain + (64 * j + lane) * 4), bs = *(const f32x4*)(bias + (64 * j + lane) * 4); xr[64 * j] = v[j] * rstd * gn + bs; }
        }
    }
#undef IN
#undef SEAM
}

extern "C" void kernel_launch(void* const* d_in, const int* in_sizes, int n_in, void* d_out, int out_size, void* d_ws, size_t ws_size, hipStream_t stream) {
    static int grid = 0;
    if (grid == 0) {
        if (n_in != 18 || in_sizes[0] != M * DM || out_size != M * DM || ws_size < WS_END) { fprintf(stderr, "kernel_launch: unexpected shapes (n_in %d, in0 %d, out %d, ws %zu); nothing launched\n", n_in, n_in > 0 ? in_sizes[0] : -1, out_size, ws_size); grid = -1; return; }
        int dev = 0, cus = 0, per_cu = 0;
        if (hipGetDevice(&dev) != hipSuccess || hipDeviceGetAttribute(&cus, hipDeviceAttributeMultiprocessorCount, dev) != hipSuccess) { grid = -1; return; }
        if (hipFuncSetAttribute((const void*)fwd_megakernel, hipFuncAttributeMaxDynamicSharedMemorySize, LDS_BYTES) != hipSuccess) { fprintf(stderr, "kernel_launch: hipFuncSetAttribute failed\n"); grid = -1; return; }
        if (hipOccupancyMaxActiveBlocksPerMultiprocessor(&per_cu, (const void*)fwd_megakernel, NWAVES * 64, LDS_BYTES) != hipSuccess || per_cu < 1) { fprintf(stderr, "kernel_launch: occupancy query says %d\n", per_cu); per_cu = 1; }
        (void)hipGetLastError();
        grid = cus * 1;
    }
    if (grid < 0) return;
    Args a{};
    for (int i = 0; i < 18; ++i) a.in[i] = (const float*)d_in[i];
    a.out = (float*)d_out; a.ws = (unsigned char*)d_ws;
#if MK_N_LAUNCHES == 1
    a.ph_lo = 0; a.ph_hi = N_PHASES;
    void* kargs[] = {&a};
    hipError_t e = hipLaunchCooperativeKernel((const void*)fwd_megakernel, dim3(grid), dim3(NWAVES * 64), kargs, LDS_BYTES, stream);
    if (e != hipSuccess) fprintf(stderr, "cooperative launch failed: %s (grid %d)\n", hipGetErrorString(e), grid);
#else
    for (int p = 0; p < N_PHASES; ++p) { a.ph_lo = p; a.ph_hi = p + 1; hipLaunchKernelGGL(fwd_megakernel, dim3(grid), dim3(NWAVES * 64), LDS_BYTES, stream, a); }
#endif
}
```

```cpp
#include <hip/hip_runtime.h>
#include <hip/hip_cooperative_groups.h>
#include <cstdio>
#include <cstdint>
namespace cg = cooperative_groups;

#ifndef MK_N_LAUNCHES
#define MK_N_LAUNCHES 1
#endif

constexpr int BATCH = 4, SEQ = 8192, DM = 2048, M = BATCH * SEQ;
constexpr int D_SSM = 1024, NG = 64, GRP = 16, NST = 64;
constexpr int NQH = 16, NKVH = 4, HD = 64, D_ATTN = 1024, D_KV = 256;
constexpr int D_IN = 8704;
constexpr float LN_EPS = 1e-5f;
constexpr float LOG2E = 1.4426950408889634f;
#define DEEPNORM_ALPHA 1.189207115002721f

namespace pg8 {
#define PG8_LAS __attribute__((address_space(3)))
typedef unsigned short bf16_t;
typedef short bf16x8 __attribute__((ext_vector_type(8)));
typedef float f32x4 __attribute__((ext_vector_type(4)));
typedef unsigned u32x4 __attribute__((ext_vector_type(4)));
constexpr int BM = 256, BK = 64, HALF = 128, HTB = HALF * BK * 2, STAGE_BYTES = 8 * HTB, NXCD = 8, WGM = 8;

__host__ __device__ __forceinline__ int lds_byte(int r, int c) { const int st = (r >> 4) * 2 + (c >> 5), rr = r & 15, cc = c & 31, ob = rr * 64 + cc * 2; return st * 1024 + (ob ^ (((ob >> 9) & 1) << 5)); }
__host__ __device__ __forceinline__ void stage_rc(int b, int& R, int& C) { const int st = b / 1024, sb = b % 1024, swz = sb ^ (((sb >> 9) & 1) << 5); R = (st >> 1) * 16 + swz / 64; C = (st & 1) * 32 + (swz % 64) / 2; }
__host__ __device__ __forceinline__ int perm32(int rho) { const int n = rho >> 4, i = rho & 15; return 8 * (i >> 2) + 4 * n + (i & 3); }

struct Unit { int pm, pn; };
struct Gemm { const bf16_t* A; const bf16_t* Bt; int K; int amode; };

struct StaticOrder {
    int nM, nN, nwg, G, c;
    __host__ __device__ void init(int M_, int N_, int G_, int c_) { nM = M_ / BM; nN = N_ / BM; nwg = nM * nN; G = G_; c = c_; }
    __host__ __device__ bool next(int i, Unit& u) const {
        const long L = (long)i * G + c; if (L >= nwg) return false;
        int wgid = (int)L; { const int q = nwg / NXCD, r = nwg % NXCD, xcd = wgid % NXCD, off = wgid / NXCD; wgid = (xcd < r ? xcd * (q + 1) : r * (q + 1) + (xcd - r) * q) + off; }
        const int nig = WGM * nN, gid = wgid / nig, fm = gid * WGM, gsz = (nM - fm) < WGM ? (nM - fm) : WGM;
        u.pm = fm + ((wgid % nig) % gsz); u.pn = (wgid % nig) / gsz; return true;
    }
    __device__ __forceinline__ void a_ready(const Unit&) const {}
    __device__ __forceinline__ void done(const Unit&) const {}
};

typedef float f32x2_t __attribute__((ext_vector_type(2))); typedef __bf16 bf16x2_t __attribute__((ext_vector_type(2)));
__device__ __forceinline__ unsigned cvt_pk_bf16(float lo, float hi) { f32x2_t v = {lo, hi}; bf16x2_t b = __builtin_convertvector(v, bf16x2_t); return __builtin_bit_cast(unsigned, b); }
__device__ __forceinline__ float bf_lo(unsigned w) { return __uint_as_float(w << 16); }
__device__ __forceinline__ float bf_hi(unsigned w) { return __uint_as_float(w & 0xffff0000u); }
__device__ __forceinline__ float sigmoid_f(float x) { return __builtin_amdgcn_rcpf(1.0f + __builtin_amdgcn_exp2f(-x * LOG2E)); }
__device__ __forceinline__ float silu_f(float x) { return x * sigmoid_f(x); }
__device__ __forceinline__ float gelu_f(float v) {
    const float av = __builtin_fabsf(v), d = av * 0.2316418882f + 1.0f, t = __builtin_amdgcn_rcpf(d);
    float q = t * 0.5307027145f + (-0.7265760135f); q = q * t + 0.7107068705f; q = q * t + (-0.142248368f); q = q * t + 0.127414796f; q = q * t;
    const float e = __builtin_amdgcn_exp2f((v * v) * (-0.72134752044f));
    const float m = v * (q * e);
    return v < 0.f ? m : v - m;
}

template <int ACT> __device__ __forceinline__ float act_f(float v) {
    if (ACT == 1) return silu_f(v);
    if (ACT == 2) return v * (0.125f * LOG2E);
    if (ACT == 3) return sigmoid_f(v);
    return v;
}
template <int ACT, bool GM> __device__ __forceinline__ void store_tile_bf16(const f32x4 (&acc)[2][2][4][2], bf16_t* base, int ld, int row0, int col0) {
#pragma unroll
    for (int ai = 0; ai < 2; ++ai)
#pragma unroll
        for (int m = 0; m < 4; ++m) { const int row = row0 + ai * HALF + m * 16;
#pragma unroll
            for (int bj = 0; bj < 2; ++bj) { const int col = col0 + bj * HALF; const f32x4 v0 = acc[ai][bj][m][0], v1 = acc[ai][bj][m][1];
                u32x4 w; w.x = cvt_pk_bf16(act_f<ACT>(v0[0]), act_f<ACT>(v0[1])); w.y = cvt_pk_bf16(act_f<ACT>(v0[2]), act_f<ACT>(v0[3]));
                w.z = cvt_pk_bf16(act_f<ACT>(v1[0]), act_f<ACT>(v1[1])); w.w = cvt_pk_bf16(act_f<ACT>(v1[2]), act_f<ACT>(v1[3]));
                bf16_t* p = GM ? base + ((size_t)((row >> 13) * 64 + (col >> 4)) * 8192 + (row & 8191)) * 16 + (col & 15) : base + (size_t)row * ld + col;
                *(u32x4*)p = w; } }
}
struct EpiInProj {
    static constexpr bool PERM = true, AFTER_DRAIN = false;
    bf16_t *U, *ZS, *Q, *Kb, *Vb, *ZA, *GS, *GA;
    __device__ __forceinline__ void operator()(const f32x4 (&acc)[2][2][4][2], const Unit& u, int wr, int wc, int fr, int fq) const {
        const int pn = u.pn, row0 = u.pm * BM + wr * 64 + fr, cw = wc * 32 + 8 * fq;
        if (pn < 4)        store_tile_bf16<0, true >(acc, U, 0, row0, pn * 256 + cw);
        else if (pn < 8)   store_tile_bf16<1, false>(acc, ZS, 1024, row0, (pn - 4) * 256 + cw);
        else if (pn < 12)  store_tile_bf16<2, false>(acc, Q, 1024, row0, (pn - 8) * 256 + cw);
        else if (pn == 12) store_tile_bf16<0, false>(acc, Kb, 256, row0, cw);
        else if (pn == 13) store_tile_bf16<0, false>(acc, Vb, 256, row0, cw);
        else if (pn < 18)  store_tile_bf16<1, false>(acc, ZA, 1024, row0, (pn - 14) * 256 + cw);
        else if (pn < 26)  store_tile_bf16<3, false>(acc, GS, 2048, row0, (pn - 18) * 256 + cw);
        else               store_tile_bf16<3, false>(acc, GA, 2048, row0, (pn - 26) * 256 + cw);
    }
};
struct EpiGlu {
    static constexpr bool PERM = true, AFTER_DRAIN = false;
    const bf16_t* ZS; bf16_t* HS;
    __device__ __forceinline__ void operator()(const f32x4 (&acc)[2][2][4][2], const Unit& u, int wr, int wc, int fr, int fq) const {
        const int row0 = u.pm * BM + wr * 64 + fr, j0 = u.pn * 128 + wc * 32 + 8 * fq;
#pragma unroll
        for (int ai = 0; ai < 2; ++ai)
#pragma unroll
            for (int m = 0; m < 4; ++m) { const size_t off = (size_t)(row0 + ai * HALF + m * 16) * 1024 + j0;
                const u32x4 z = *(const u32x4*)(ZS + off);
                const f32x4 a0 = acc[ai][0][m][0], a1 = acc[ai][0][m][1], b0 = acc[ai][1][m][0], b1 = acc[ai][1][m][1];
                u32x4 w;
                w.x = cvt_pk_bf16(a0[0] * sigmoid_f(b0[0]) * bf_lo(z.x), a0[1] * sigmoid_f(b0[1]) * bf_hi(z.x));
                w.y = cvt_pk_bf16(a0[2] * sigmoid_f(b0[2]) * bf_lo(z.y), a0[3] * sigmoid_f(b0[3]) * bf_hi(z.y));
                w.z = cvt_pk_bf16(a1[0] * sigmoid_f(b1[0]) * bf_lo(z.z), a1[1] * sigmoid_f(b1[1]) * bf_hi(z.z));
                w.w = cvt_pk_bf16(a1[2] * sigmoid_f(b1[2]) * bf_lo(z.w), a1[3] * sigmoid_f(b1[3]) * bf_hi(z.w));
                *(u32x4*)(HS + off) = w; }
    }
};
template <bool ADD> struct EpiGate {
    static constexpr bool PERM = true, AFTER_DRAIN = false;
    const bf16_t* G; bf16_t* O;
    __device__ __forceinline__ void operator()(const f32x4 (&acc)[2][2][4][2], const Unit& u, int wr, int wc, int fr, int fq) const {
        const int row0 = u.pm * BM + wr * 64 + fr, col0 = u.pn * BM + wc * 32 + 8 * fq;
#pragma unroll
        for (int ai = 0; ai < 2; ++ai)
#pragma unroll
            for (int m = 0; m < 4; ++m)
#pragma unroll
                for (int bj = 0; bj < 2; ++bj) { const size_t off = (size_t)(row0 + ai * HALF + m * 16) * 2048 + col0 + bj * HALF;
                    const u32x4 g = *(const u32x4*)(G + off); const f32x4 v0 = acc[ai][bj][m][0], v1 = acc[ai][bj][m][1];
                    float o[8] = {v0[0] * bf_lo(g.x), v0[1] * bf_hi(g.x), v0[2] * bf_lo(g.y), v0[3] * bf_hi(g.y), v1[0] * bf_lo(g.z), v1[1] * bf_hi(g.z), v1[2] * bf_lo(g.w), v1[3] * bf_hi(g.w)};
                    if (ADD) { const u32x4 p = *(const u32x4*)(O + off);
                        o[0] += bf_lo(p.x); o[1] += bf_hi(p.x); o[2] += bf_lo(p.y); o[3] += bf_hi(p.y); o[4] += bf_lo(p.z); o[5] += bf_hi(p.z); o[6] += bf_lo(p.w); o[7] += bf_hi(p.w); }
                    u32x4 w; w.x = cvt_pk_bf16(o[0], o[1]); w.y = cvt_pk_bf16(o[2], o[3]); w.z = cvt_pk_bf16(o[4], o[5]); w.w = cvt_pk_bf16(o[6], o[7]);
                    *(u32x4*)(O + off) = w; }
    }
};
struct EpiResid {
    static constexpr bool PERM = false, AFTER_DRAIN = false;
    const float* X; float* C;
    __device__ __forceinline__ void operator()(const f32x4 (&acc)[2][2][4][2], const Unit& u, int wr, int wc, int fr, int fq) const {
        const int row0 = u.pm * BM + wr * 64 + fr, col0 = u.pn * BM + wc * 32 + 4 * fq;
#pragma unroll
        for (int ai = 0; ai < 2; ++ai)
#pragma unroll
            for (int m = 0; m < 4; ++m) { const size_t ro = (size_t)(row0 + ai * HALF + m * 16) * DM + col0;
#pragma unroll
                for (int bj = 0; bj < 2; ++bj)
#pragma unroll
                    for (int n = 0; n < 2; ++n) { const f32x4 xv = *(const f32x4*)(X + ro + bj * HALF + n * 16); *(f32x4*)(C + ro + bj * HALF + n * 16) = xv * DEEPNORM_ALPHA + acc[ai][bj][m][n]; } }
    }
};

template <class Epi, class Sched, bool ALIGN_EPI = false, bool SP2 = false>
__device__ __forceinline__ void gemm_phase(PG8_LAS unsigned char* lds, const Gemm g, const Sched& S, const Epi& E) {
    const int tid = threadIdx.x, wid = __builtin_amdgcn_readfirstlane(tid >> 6), lane = tid & 63, wr = wid >> 2, wc = wid & 3, fr = lane & 15, fq = lane >> 4;
    const int K = g.K, nt = K / BK;
    unsigned voffA[2], voffB[2];
#pragma unroll
    for (int i = 0; i < 2; ++i) { int R, C; stage_rc(tid * 16 + i * 8192, R, C); const int Rb = Epi::PERM ? ((R & ~31) + perm32(R & 31)) : R;
        voffA[i] = g.amode ? (unsigned)((((C >> 4) * 8192 + R) * 16 + (C & 15)) * 2) : (unsigned)(R * K + C) * 2u;
        voffB[i] = (unsigned)(Rb * K + C) * 2u; }
    const size_t kstepB = (size_t)(BK * 2), hstepB = (size_t)HALF * K * 2, tstepB = 2 * hstepB;
    const size_t kstepA = g.amode ? (size_t)4 * 8192 * 32 : (size_t)(BK * 2), hstepA = g.amode ? (size_t)HALF * 32 : (size_t)HALF * K * 2;
#define PG8_TILEA(pm) (g.amode ? (const char*)g.A + ((size_t)((pm) >> 5) * 64 * 8192 + (size_t)((pm) & 31) * 256) * 32 : (const char*)g.A + (size_t)(pm) * 2 * hstepA)
    const unsigned ldsw = (unsigned)wid * 1024u;
    const int aoff = lds_byte(wr * 64 + fr, fq * 8), boff = lds_byte(wc * 32 + fr, fq * 8);
#define PG8_SA(b, h) (((b) * 2 + (h)) * HTB)
#define PG8_SB(b, h) ((4 + (b) * 2 + (h)) * HTB)
#define PG8_STAGE(bufoff, gbase, voff) do { _Pragma("unroll") for (int _i = 0; _i < 2; ++_i) \
        __builtin_amdgcn_global_load_lds((const unsigned*)((const char*)(gbase) + (voff)[_i]), (PG8_LAS unsigned*)(lds + (bufoff) + ldsw + _i * 8192), 16, 0, 0); } while (0)
#define PG8_LDA(dst, b, h) do { _Pragma("unroll") for (int m = 0; m < 4; ++m) _Pragma("unroll") for (int k = 0; k < 2; ++k) dst[m][k] = *(const PG8_LAS bf16x8*)(lds + PG8_SA(b, h) + aoff + m * 2048 + k * 1024); } while (0)
#define PG8_LDB(dst, b, h) do { _Pragma("unroll") for (int n = 0; n < 2; ++n) _Pragma("unroll") for (int k = 0; k < 2; ++k) dst[n][k] = *(const PG8_LAS bf16x8*)(lds + PG8_SB(b, h) + boff + n * 2048 + k * 1024); } while (0)
#define PG8_MMA(ai, bj, At, Bt) do { __builtin_amdgcn_s_setprio(1); _Pragma("unroll") for (int m = 0; m < 4; ++m) _Pragma("unroll") for (int n = 0; n < 2; ++n) _Pragma("unroll") for (int k = 0; k < 2; ++k) \
        acc[ai][bj][m][n] = __builtin_amdgcn_mfma_f32_16x16x32_bf16(Bt[n][k], At[m][k], acc[ai][bj][m][n], 0, 0, 0); __builtin_amdgcn_s_setprio(0); } while (0)
#define PG8_WAIT_V(n) asm volatile("s_waitcnt vmcnt(" #n ")" ::: "memory")
#define PG8_WAIT_L(n) asm volatile("s_waitcnt lgkmcnt(" #n ")" ::: "memory")
#define PG8_BAR __builtin_amdgcn_s_barrier()
#define PG8_SCHED __builtin_amdgcn_sched_barrier(0)
    Unit cur, nxt; int ui = 0;
    if (!S.next(0, cur)) return;
    f32x4 acc[2][2][4][2];
#pragma unroll
    for (int a = 0; a < 2; ++a)
#pragma unroll
        for (int b = 0; b < 2; ++b)
#pragma unroll
            for (int m = 0; m < 4; ++m)
#pragma unroll
                for (int n = 0; n < 2; ++n) acc[a][b][m][n] = (f32x4){0.f, 0.f, 0.f, 0.f};
    bf16x8 At[4][2], B0[2][2], B1[2][2];
    const char* cA = PG8_TILEA(cur.pm); const char* cB = (const char*)g.Bt + (size_t)cur.pn * tstepB;
    S.a_ready(cur);
    if constexpr (SP2) {
        PG8_STAGE(PG8_SB(0, 0), cB, voffB); PG8_STAGE(PG8_SB(0, 1), cB + hstepB, voffB); PG8_STAGE(PG8_SA(0, 0), cA, voffA); PG8_STAGE(PG8_SA(0, 1), cA + hstepA, voffA);
        if (wr == 1) PG8_BAR;
        PG8_WAIT_V(2); PG8_BAR;
        PG8_STAGE(PG8_SB(1, 0), cB + kstepB, voffB); PG8_STAGE(PG8_SA(1, 0), cA + kstepA, voffA); PG8_STAGE(PG8_SB(1, 1), cB + hstepB + kstepB, voffB);
        PG8_WAIT_V(6); PG8_BAR;
    } else {
        PG8_STAGE(PG8_SB(0, 0), cB, voffB); PG8_STAGE(PG8_SA(0, 0), cA, voffA); PG8_STAGE(PG8_SB(0, 1), cB + hstepB, voffB); PG8_STAGE(PG8_SA(0, 1), cA + hstepA, voffA);
        if (wr == 1) PG8_BAR;
        PG8_WAIT_V(4); PG8_BAR;
        PG8_STAGE(PG8_SB(1, 0), cB + kstepB, voffB); PG8_STAGE(PG8_SA(1, 0), cA + kstepA, voffA); PG8_STAGE(PG8_SB(1, 1), cB + hstepB + kstepB, voffB);
        PG8_WAIT_V(6); PG8_BAR;
    }
    for (;;) {
        const bool has_next = S.next(ui + 1, nxt);
        const char* nA = has_next ? PG8_TILEA(nxt.pm) : cA; const char* nB = has_next ? (const char*)g.Bt + (size_t)nxt.pn * tstepB : cB;
        for (int t = 0; t < nt; t += 2) {
            const bool last = (t == nt - 2);
            const char* a1 = cA + (size_t)(t + 1) * kstepA;
            const char* a2 = last ? nA : cA + (size_t)(t + 2) * kstepA; const char* b2 = last ? nB : cB + (size_t)(t + 2) * kstepB;
            const char* a3 = a2 + kstepA; const char* b3 = b2 + kstepB;
            if (last && has_next) S.a_ready(nxt);
            if constexpr (SP2) {
            PG8_LDB(B0, 0, 0); PG8_LDB(B1, 0, 1); PG8_SCHED; PG8_LDA(At, 0, 0); PG8_STAGE(PG8_SA(1, 1), a1 + hstepA, voffA);
            PG8_WAIT_V(8); PG8_WAIT_L(0); PG8_BAR; PG8_MMA(0, 0, At, B0); PG8_MMA(0, 1, At, B1); PG8_BAR; PG8_SCHED;
            PG8_LDA(At, 0, 1); PG8_STAGE(PG8_SB(0, 0), b2, voffB); PG8_STAGE(PG8_SB(0, 1), b2 + hstepB, voffB); PG8_STAGE(PG8_SA(0, 0), a2, voffA);
            PG8_WAIT_V(8); PG8_WAIT_L(0); PG8_BAR; PG8_MMA(1, 0, At, B0); PG8_MMA(1, 1, At, B1); PG8_BAR; PG8_SCHED;
            PG8_LDB(B0, 1, 0); PG8_LDB(B1, 1, 1); PG8_SCHED; PG8_LDA(At, 1, 0); PG8_STAGE(PG8_SA(0, 1), a2 + hstepA, voffA);
            PG8_WAIT_V(8); PG8_WAIT_L(0); PG8_BAR; PG8_MMA(0, 0, At, B0); PG8_MMA(0, 1, At, B1); PG8_BAR; PG8_SCHED;
            PG8_LDA(At, 1, 1); PG8_STAGE(PG8_SB(1, 0), b3, voffB); PG8_STAGE(PG8_SB(1, 1), b3 + hstepB, voffB); PG8_STAGE(PG8_SA(1, 0), a3, voffA);
            PG8_WAIT_V(8); PG8_WAIT_L(0); PG8_BAR; PG8_MMA(1, 0, At, B0); PG8_MMA(1, 1, At, B1); PG8_BAR; PG8_SCHED;
            } else {
            PG8_LDB(B0, 0, 0); PG8_SCHED; PG8_LDA(At, 0, 0); PG8_STAGE(PG8_SA(1, 1), a1 + hstepA, voffA);
            PG8_WAIT_L(8); PG8_BAR; PG8_WAIT_L(0); PG8_MMA(0, 0, At, B0); PG8_BAR; PG8_SCHED;
            PG8_LDB(B1, 0, 1); PG8_STAGE(PG8_SB(0, 0), b2, voffB);
            PG8_BAR; PG8_WAIT_L(0); PG8_MMA(0, 1, At, B1); PG8_BAR;
            PG8_LDA(At, 0, 1); PG8_STAGE(PG8_SA(0, 0), a2, voffA);
            PG8_BAR; PG8_WAIT_L(0); PG8_MMA(1, 0, At, B0); PG8_BAR; PG8_SCHED;
            PG8_STAGE(PG8_SB(0, 1), b2 + hstepB, voffB);
            PG8_WAIT_V(6); PG8_BAR; PG8_MMA(1, 1, At, B1); PG8_BAR;
            PG8_LDB(B0, 1, 0); PG8_SCHED; PG8_LDA(At, 1, 0); PG8_STAGE(PG8_SA(0, 1), a2 + hstepA, voffA);
            PG8_WAIT_L(8); PG8_BAR; PG8_WAIT_L(0); PG8_MMA(0, 0, At, B0); PG8_BAR; PG8_SCHED;
            PG8_LDB(B1, 1, 1); PG8_STAGE(PG8_SB(1, 0), b3, voffB);
            PG8_BAR; PG8_WAIT_L(0); PG8_MMA(0, 1, At, B1); PG8_BAR;
            PG8_LDA(At, 1, 1); PG8_STAGE(PG8_SA(1, 0), a3, voffA);
            PG8_BAR; PG8_WAIT_L(0); PG8_MMA(1, 0, At, B0); PG8_BAR; PG8_SCHED;
            PG8_STAGE(PG8_SB(1, 1), b3 + hstepB, voffB);
            PG8_WAIT_V(6); PG8_BAR; PG8_MMA(1, 1, At, B1); PG8_BAR;
            }
        }
        if constexpr (ALIGN_EPI) { if (wr == 0) PG8_BAR; }
        if constexpr (!Epi::AFTER_DRAIN) { E(acc, cur, wr, wc, fr, fq); S.done(cur); }
        if (!has_next) break;
#pragma unroll
        for (int a = 0; a < 2; ++a)
#pragma unroll
            for (int b = 0; b < 2; ++b)
#pragma unroll
                for (int m = 0; m < 4; ++m)
#pragma unroll
                    for (int n = 0; n < 2; ++n) acc[a][b][m][n] = (f32x4){0.f, 0.f, 0.f, 0.f};
        cur = nxt; cA = nA; cB = nB; ++ui;
        if constexpr (ALIGN_EPI) { if (wr == 1) PG8_BAR; }
    }
    PG8_WAIT_V(0);
    if constexpr (!ALIGN_EPI) { if (wr == 0) PG8_BAR; }
    PG8_BAR;
#undef PG8_TILEA
#undef PG8_SA
#undef PG8_SB
#undef PG8_STAGE
#undef PG8_LDA
#undef PG8_LDB
#undef PG8_MMA
#undef PG8_WAIT_V
#undef PG8_WAIT_L
#undef PG8_BAR
#undef PG8_SCHED
}
}

constexpr int NWAVES = 8;
constexpr int N_PHASES = 8;
constexpr size_t MiB = 1u << 20;
constexpr size_t WS_CTL = 0;
constexpr size_t WS_XBAR = 16 * 1024;
constexpr size_t WS_BIAS = 64 * 1024;
constexpr size_t WS_WIN = 1 * MiB;
constexpr size_t WS_WGLU = 36 * MiB;
constexpr size_t WS_WBS = 40 * MiB, WS_WBA = 44 * MiB;
constexpr size_t WS_WOUT = 48 * MiB;
constexpr size_t WS_XB = 64 * MiB;
constexpr size_t WS_U = 192 * MiB;
constexpr size_t WS_ZS = 256 * MiB;
constexpr size_t WS_Q = 320 * MiB;
constexpr size_t WS_K = 384 * MiB, WS_V = 400 * MiB;
constexpr size_t WS_ZA = 416 * MiB;
constexpr size_t WS_GS = 480 * MiB, WS_GA = 608 * MiB;
constexpr size_t WS_Y = 736 * MiB;
constexpr size_t WS_HA = 800 * MiB;
constexpr size_t WS_TTAB = 56 * MiB;
constexpr size_t WS_FTAB = 57 * MiB;
constexpr size_t WS_AL = 61 * MiB;
constexpr size_t WS_GTAB = 864 * MiB;
constexpr size_t WS_END = 868 * MiB;

constexpr int RING_BYTES = 131072, LDS_BYTES = 147456;

#define GAS __attribute__((address_space(1)))
#define LAS __attribute__((address_space(3)))
typedef unsigned short bf16;
typedef unsigned v4u __attribute__((ext_vector_type(4)));
typedef float f32x4 __attribute__((ext_vector_type(4)));
#define LDS_WAIT() asm volatile("s_waitcnt lgkmcnt(0)" ::: "memory")
__device__ __forceinline__ unsigned f2bf(float f) { unsigned u = __builtin_bit_cast(unsigned, f); return (u + 0x7fffu + ((u >> 16) & 1u)) >> 16; }
__device__ __forceinline__ unsigned pk2(float lo, float hi) { return f2bf(lo) | (f2bf(hi) << 16); }
__device__ __forceinline__ float bf2f(unsigned short h) { return __uint_as_float(((unsigned)h) << 16); }

__device__ __forceinline__ void p0_transpose_item(const float* W, int K, int N, bf16* WT, int k0, int n0, int wt_row0, LAS float* scr, int lane) {
#pragma unroll 8
    for (int i = 0; i < 32; ++i) { const int kk = 2 * i + (lane >> 5); scr[kk * 33 + (lane & 31)] = W[(size_t)(k0 + kk) * N + n0 + (lane & 31)]; }
    LDS_WAIT(); asm volatile("" ::: "memory");
    const int c = lane & 7;
#pragma unroll
    for (int j = 0; j < 4; ++j) { const int n = (lane >> 3) + 8 * j; const LAS float* s = scr + (8 * c) * 33 + n;
        v4u o; o.x = pk2(s[0 * 33], s[1 * 33]); o.y = pk2(s[2 * 33], s[3 * 33]); o.z = pk2(s[4 * 33], s[5 * 33]); o.w = pk2(s[6 * 33], s[7 * 33]);
        *(GAS v4u*)(WT + (size_t)(wt_row0 + n) * K + k0 + 8 * c) = o; }
    LDS_WAIT(); asm volatile("" ::: "memory");
}

__device__ __forceinline__ int t5_bucket(int dist) {
    if (dist < 16) return dist;
    const float d = (float)dist;
    int large = 16 + (int)(logf(d / 16.0f) / logf(8.0f) * 16.0f);
    return large < 31 ? large : 31;
}

#define XB_TMO      128
#define XB_XCNT(j)  (256  + 64 * (j))
#define XB_XSUB(j)  (1280 + 64 * (j))
#define XB_XGEN(j)  (2304 + 64 * (j))
#define XB_TOP      3328
#define XB_TOPGEN   3392
#define XCD_BAR_WORDS 3456
#define XB_SPIN_CAP (1u << 18)
__device__ __forceinline__ unsigned xb_ld(unsigned* p)              { return __hip_atomic_load(p, __ATOMIC_RELAXED, __HIP_MEMORY_SCOPE_AGENT); }
__device__ __forceinline__ unsigned xb_add(unsigned* p, unsigned v) { return __hip_atomic_fetch_add(p, v, __ATOMIC_RELAXED, __HIP_MEMORY_SCOPE_AGENT); }
__device__ __forceinline__ unsigned xb_xcc_id() { return (unsigned)__builtin_amdgcn_s_getreg((3 << 11) | 20) & 0xFu; }
#define XB_SPIN(cond, bar) do { unsigned _sp = 0; while (cond) { __builtin_amdgcn_s_sleep(1); \
    if ((++_sp & 255u) == 0u) { if (xb_ld(&(bar)[XB_TMO])) break; if (_sp > XB_SPIN_CAP) { atomicAdd(&(bar)[XB_TMO], 1u); break; } } } } while (0)
struct XcdBarrier { unsigned* bar; unsigned x; volatile LAS unsigned* st; };
__device__ __forceinline__ XcdBarrier xcd_barrier_post(unsigned* bar, volatile LAS unsigned* st) {
    XcdBarrier b; b.bar = bar; b.x = xb_xcc_id(); b.st = st;
    if (threadIdx.x == 0) (void)xb_add(&bar[XB_XCNT(b.x)], 1u);
    return b;
}
__device__ __forceinline__ void xcd_barrier_complete(unsigned* bar, unsigned x, unsigned& nloc, unsigned& nx) {
    const unsigned G = gridDim.x * gridDim.y * gridDim.z;
    unsigned sum, cnt, mine, sp = 0u;
    for (;;) {
        sum = 0u; cnt = 0u; mine = 0u;
#pragma unroll
        for (unsigned j = 0; j < 16; ++j) { const unsigned c = xb_ld(&bar[XB_XCNT(j)]); sum += c; cnt += (c > 0u) ? 1u : 0u; mine = (j == x) ? c : mine; }
        if (sum == G) break;
        __builtin_amdgcn_s_sleep(1);
        if ((++sp & 255u) == 0u) { if (xb_ld(&bar[XB_TMO])) break; if (sp > XB_SPIN_CAP) { atomicAdd(&bar[XB_TMO], 1u); break; } }
    }
    nloc = mine > 0u ? mine : 1u; nx = cnt > 0u ? cnt : 1u;
}
__device__ __forceinline__ void xcd_barrier(const XcdBarrier& b) {
    asm volatile("s_waitcnt vmcnt(0)" ::: "memory");
    __syncthreads();
    if (threadIdx.x == 0) {
        unsigned* bar = b.bar;
        __builtin_amdgcn_s_waitcnt(0);
        unsigned nloc = b.st[0], nx = b.st[1];
        if (nloc == 0u) { xcd_barrier_complete(bar, b.x, nloc, nx); b.st[0] = nloc; b.st[1] = nx; }
        const unsigned old = xb_add(&bar[XB_XSUB(b.x)], 1u);
        const unsigned gen = old / nloc;
        if (old + 1u == (gen + 1u) * nloc) {
            __builtin_amdgcn_fence(__ATOMIC_RELEASE, "agent");
            asm volatile("s_waitcnt vmcnt(0)" ::: "memory");
            const unsigned og = xb_add(&bar[XB_TOP], 1u);
            const unsigned tg = og / nx;
            if (og + 1u == (tg + 1u) * nx) xb_add(&bar[XB_TOPGEN], 1u);
            else XB_SPIN(xb_ld(&bar[XB_TOPGEN]) == tg, bar);
            __builtin_amdgcn_fence(__ATOMIC_ACQUIRE, "agent");
            xb_add(&bar[XB_XGEN(b.x)], 1u);
            asm volatile("s_waitcnt vmcnt(0)" ::: "memory");
        } else {
            XB_SPIN(xb_ld(&bar[XB_XGEN(b.x)]) == gen, bar);
            __builtin_amdgcn_fence(__ATOMIC_ACQUIRE, "agent");
            asm volatile("s_waitcnt vmcnt(0)" ::: "memory");
        }
    }
    __syncthreads();
}

struct Args { const float* in[18]; float* out; unsigned char* ws; int ph_lo, ph_hi; };

__device__ __forceinline__ void ssm_simple_unit(const Args& a, int unit, int lane) {
    const int b = unit >> 6, g = unit & 63, p = lane;
    const float* lam_re = a.in[2]; const float* lam_im = a.in[3]; const float* b_re = a.in[4]; const float* b_im = a.in[5];
    const float* c_re = a.in[6]; const float* c_im = a.in[7]; const float* dsk = a.in[8]; const float* lstep = a.in[9];
    const float step = expf(lstep[g]);
    const float lr = lam_re[g * 64 + p], li = lam_im[g * 64 + p];
    const float mag = expf(lr * step); float sn, cs; sincosf(li * step, &sn, &cs);
    const float ar = mag * cs, ai = mag * sn;
    const float nr = ar - 1.0f, ni = ai, den = lr * lr + li * li;
    const float fr = (nr * lr + ni * li) / den, fi = (ni * lr - nr * li) / den;
    float bbr[16], bbi[16], cr[16], ci[16], dd[16];
#pragma unroll
    for (int h = 0; h < 16; ++h) { const float br = b_re[(g * 64 + p) * 16 + h], bi = b_im[(g * 64 + p) * 16 + h];
        bbr[h] = fr * br - fi * bi; bbi[h] = fr * bi + fi * br;
        cr[h] = c_re[(g * 16 + h) * 64 + p]; ci[h] = c_im[(g * 16 + h) * 64 + p]; dd[h] = dsk[g * 16 + h]; }
    const bf16* U = (const bf16*)(a.ws + WS_U) + (size_t)(b * 64 + g) * 8192 * 16;
    bf16* Y = (bf16*)(a.ws + WS_Y) + (size_t)(b * 64 + g) * 8192 * 16;
    const int hown = 8 * (lane & 1) + 4 * ((lane >> 1) & 1) + 2 * ((lane >> 2) & 1) + ((lane >> 3) & 1);
    float sr = 0.f, si = 0.f;
    for (int t = 0; t < 8192; ++t) {
        const v4u u0 = *(const v4u*)(U + (size_t)t * 16), u1 = *(const v4u*)(U + (size_t)t * 16 + 8);
        float u[16] = {pg8::bf_lo(u0.x), pg8::bf_hi(u0.x), pg8::bf_lo(u0.y), pg8::bf_hi(u0.y), pg8::bf_lo(u0.z), pg8::bf_hi(u0.z), pg8::bf_lo(u0.w), pg8::bf_hi(u0.w),
                       pg8::bf_lo(u1.x), pg8::bf_hi(u1.x), pg8::bf_lo(u1.y), pg8::bf_hi(u1.y), pg8::bf_lo(u1.z), pg8::bf_hi(u1.z), pg8::bf_lo(u1.w), pg8::bf_hi(u1.w)};
        float bur = 0.f, bui = 0.f;
#pragma unroll
        for (int h = 0; h < 16; ++h) { bur += bbr[h] * u[h]; bui += bbi[h] * u[h]; }
        const float nsr = ar * sr - ai * si + bur, nsi = ar * si + ai * sr + bui; sr = nsr; si = nsi;
        float z[16];
#pragma unroll
        for (int h = 0; h < 16; ++h) z[h] = cr[h] * sr - ci[h] * si;
#pragma unroll
        for (int i = 0; i < 8; ++i) { const bool up = (lane & 1) != 0; const float send = up ? z[i] : z[i + 8], keep = up ? z[i + 8] : z[i]; z[i] = keep + __shfl_xor(send, 1); }
#pragma unroll
        for (int i = 0; i < 4; ++i) { const bool up = (lane & 2) != 0; const float send = up ? z[i] : z[i + 4], keep = up ? z[i + 4] : z[i]; z[i] = keep + __shfl_xor(send, 2); }
#pragma unroll
        for (int i = 0; i < 2; ++i) { const bool up = (lane & 4) != 0; const float send = up ? z[i] : z[i + 2], keep = up ? z[i + 2] : z[i]; z[i] = keep + __shfl_xor(send, 4); }
        { const bool up = (lane & 8) != 0; const float send = up ? z[0] : z[1], keep = up ? z[1] : z[0]; z[0] = keep + __shfl_xor(send, 8); }
        float tot = z[0]; tot += __shfl_xor(tot, 16); tot += __shfl_xor(tot, 32);
        float uo = 0.f, dv = 0.f;
#pragma unroll
        for (int h = 0; h < 16; ++h) { if (h == hown) { uo = u[h]; dv = dd[h]; } }
        const float y = tot + dv * uo;
        if (lane < 16) Y[(size_t)t * 16 + hown] = (bf16)f2bf(pg8::gelu_f(y));
    }
}

__device__ __forceinline__ void attn_simple_item(const Args& a, int item) {
    const int row = item >> 4, h = item & 15, kvh = h >> 2, t = row & 8191;
    const bf16* Q = (const bf16*)(a.ws + WS_Q); const bf16* Kb = (const bf16*)(a.ws + WS_K); const bf16* Vb = (const bf16*)(a.ws + WS_V);
    const bf16* ZA = (const bf16*)(a.ws + WS_ZA); bf16* HA = (bf16*)(a.ws + WS_HA);
    const float* biasd = (const float*)(a.ws + WS_BIAS) + h * 128;
    float q[64], o[64];
#pragma unroll
    for (int c = 0; c < 8; ++c) { const v4u w = *(const v4u*)(Q + (size_t)row * 1024 + h * 64 + c * 8);
        q[c * 8 + 0] = pg8::bf_lo(w.x); q[c * 8 + 1] = pg8::bf_hi(w.x); q[c * 8 + 2] = pg8::bf_lo(w.y); q[c * 8 + 3] = pg8::bf_hi(w.y);
        q[c * 8 + 4] = pg8::bf_lo(w.z); q[c * 8 + 5] = pg8::bf_hi(w.z); q[c * 8 + 6] = pg8::bf_lo(w.w); q[c * 8 + 7] = pg8::bf_hi(w.w); }
#pragma unroll
    for (int d = 0; d < 64; ++d) o[d] = 0.f;
    float mx = a.in[11][h] * LOG2E, l = 1.0f;
    const int nd = t < 127 ? t : 127;
    for (int dist = 0; dist <= nd; ++dist) {
        const size_t kr = (size_t)(row - dist) * 256 + kvh * 64;
        float s = 0.f;
#pragma unroll
        for (int c = 0; c < 8; ++c) { const v4u w = *(const v4u*)(Kb + kr + c * 8);
            s += q[c * 8 + 0] * pg8::bf_lo(w.x) + q[c * 8 + 1] * pg8::bf_hi(w.x) + q[c * 8 + 2] * pg8::bf_lo(w.y) + q[c * 8 + 3] * pg8::bf_hi(w.y)
               + q[c * 8 + 4] * pg8::bf_lo(w.z) + q[c * 8 + 5] * pg8::bf_hi(w.z) + q[c * 8 + 6] * pg8::bf_lo(w.w) + q[c * 8 + 7] * pg8::bf_hi(w.w); }
        s += biasd[dist];
        const float mn = fmaxf(mx, s), sc = exp2f(mx - mn), pr = exp2f(s - mn);
        l = l * sc + pr; mx = mn;
#pragma unroll
        for (int c = 0; c < 8; ++c) { const v4u w = *(const v4u*)(Vb + kr + c * 8);
            o[c * 8 + 0] = o[c * 8 + 0] * sc + pr * pg8::bf_lo(w.x); o[c * 8 + 1] = o[c * 8 + 1] * sc + pr * pg8::bf_hi(w.x);
            o[c * 8 + 2] = o[c * 8 + 2] * sc + pr * pg8::bf_lo(w.y); o[c * 8 + 3] = o[c * 8 + 3] * sc + pr * pg8::bf_hi(w.y);
            o[c * 8 + 4] = o[c * 8 + 4] * sc + pr * pg8::bf_lo(w.z); o[c * 8 + 5] = o[c * 8 + 5] * sc + pr * pg8::bf_hi(w.z);
            o[c * 8 + 6] = o[c * 8 + 6] * sc + pr * pg8::bf_lo(w.w); o[c * 8 + 7] = o[c * 8 + 7] * sc + pr * pg8::bf_hi(w.w); }
    }
    const float rl = 1.0f / l;
#pragma unroll
    for (int c = 0; c < 8; ++c) { const size_t off = (size_t)row * 1024 + h * 64 + c * 8; const v4u z = *(const v4u*)(ZA + off);
        v4u w; w.x = pk2(o[c * 8 + 0] * rl * pg8::bf_lo(z.x), o[c * 8 + 1] * rl * pg8::bf_hi(z.x)); w.y = pk2(o[c * 8 + 2] * rl * pg8::bf_lo(z.y), o[c * 8 + 3] * rl * pg8::bf_hi(z.y));
        w.z = pk2(o[c * 8 + 4] * rl * pg8::bf_lo(z.z), o[c * 8 + 5] * rl * pg8::bf_hi(z.z)); w.w = pk2(o[c * 8 + 6] * rl * pg8::bf_lo(z.w), o[c * 8 + 7] * rl * pg8::bf_hi(z.w));
        *(v4u*)(HA + off) = w; }
}


#ifndef SIMPLE_SSM
#define SIMPLE_SSM 0
#endif
#ifndef SIMPLE_ATTN
#define SIMPLE_ATTN 0
#endif
typedef short bf16x8_t __attribute__((ext_vector_type(8)));
typedef float f32x16 __attribute__((ext_vector_type(16)));
typedef short v4i16_t __attribute__((ext_vector_type(4)));
typedef unsigned v2u __attribute__((ext_vector_type(2)));
typedef float f32x2v __attribute__((ext_vector_type(2)));

__device__ __forceinline__ void ssm_tables(const Args& a, LAS unsigned char* L, int tg, int tid) {
    const int g = tg & 63, quarter = tg >> 6;
    LAS f32x2v* pw = (LAS f32x2v*)L;
    LAS f32x2v* bb = (LAS f32x2v*)(L + 8704);
    LAS f32x2v* cc = (LAS f32x2v*)(L + 8704 + 8192);
    const float* lam_re = a.in[2]; const float* lam_im = a.in[3]; const float* b_re = a.in[4]; const float* b_im = a.in[5];
    const float* c_re = a.in[6]; const float* c_im = a.in[7];
    const float step = expf(a.in[9][g]);
    for (int idx = tid; idx < 17 * 64; idx += 512) { const int d = idx >> 6, p = idx & 63; const float lr = lam_re[g * 64 + p], li = lam_im[g * 64 + p];
        const float mag = expf(lr * step * (float)d); float sn, cs; sincosf(li * step * (float)d, &sn, &cs); pw[idx] = (f32x2v){mag * cs, mag * sn}; }
    for (int idx = tid; idx < 1024; idx += 512) { const int p = idx >> 4, h = idx & 15; const float lr = lam_re[g * 64 + p], li = lam_im[g * 64 + p];
        const float mag = expf(lr * step); float sn, cs; sincosf(li * step, &sn, &cs);
        const float nr = mag * cs - 1.0f, ni = mag * sn, den = lr * lr + li * li, fr = (nr * lr + ni * li) / den, fi = (ni * lr - nr * li) / den;
        const float br = b_re[(g * 64 + p) * 16 + h], bi = b_im[(g * 64 + p) * 16 + h]; bb[idx] = (f32x2v){fr * br - fi * bi, fr * bi + fi * br}; }
    for (int idx = tid; idx < 1024; idx += 512) { const int h = idx >> 6, p = idx & 63; cc[idx] = (f32x2v){c_re[(g * 16 + h) * 64 + p], c_im[(g * 16 + h) * 64 + p]}; }
    __syncthreads();
    for (int k = 0; k < 5; ++k) { const int q = quarter * 512 + tid + 2048 * k; if (q >= 9216) break;
        const int l = q & 63, r = l & 31, hh = l >> 5; float v[8]; bf16* dst;
        if (q < 1024) { const int dd = (q >> 6) - 1 + (r >> 4), h = r & 15;
#pragma unroll
            for (int jj = 0; jj < 8; ++jj) v[jj] = 0.f;
            if (dd >= 0) for (int p = 0; p < 64; ++p) { const f32x2v c = cc[h * 64 + p], w = pw[dd * 64 + p]; const float ar = c.x * w.x - c.y * w.y, ai = c.x * w.y + c.y * w.x;
#pragma unroll
                for (int jj = 0; jj < 8; ++jj) { const f32x2v bq = bb[p * 16 + 8 * hh + jj]; v[jj] += ar * bq.x - ai * bq.y; } }
            dst = (bf16*)(a.ws + WS_TTAB) + ((size_t)g * 1024 + q) * 8;
        } else if (q < 5120) { const int q2 = q - 1024, pb = q2 >> 10, j = (q2 >> 6) & 15, p2 = 32 * pb + r, p = p2 & 63; const f32x2v w = pw[(15 - j) * 64 + p];
#pragma unroll
            for (int jj = 0; jj < 8; ++jj) { const f32x2v bq = bb[p * 16 + 8 * hh + jj]; v[jj] = p2 < 64 ? (w.x * bq.x - w.y * bq.y) : (w.x * bq.y + w.y * bq.x); }
            dst = (bf16*)(a.ws + WS_FTAB) + ((size_t)g * 4096 + q2) * 8;
        } else { const int q3 = q - 5120, rb = q3 >> 9, kk = (q3 >> 6) & 7, R = 32 * rb + r, t = R >> 4, h = R & 15;
#pragma unroll
            for (int jj = 0; jj < 8; ++jj) { const int p2 = 16 * kk + 8 * hh + jj, p = p2 & 63; const f32x2v c = cc[h * 64 + p], w = pw[(t + 1) * 64 + p];
                v[jj] = p2 < 64 ? (c.x * w.x - c.y * w.y) : -(c.x * w.y + c.y * w.x); }
            dst = (bf16*)(a.ws + WS_GTAB) + ((size_t)g * 4096 + q3) * 8;
        }
        v4u o; o.x = pk2(v[0], v[1]); o.y = pk2(v[2], v[3]); o.z = pk2(v[4], v[5]); o.w = pk2(v[6], v[7]); *(v4u*)dst = o;
    }
    if (quarter == 0 && tid < 64) ((f32x2v*)(a.ws + WS_AL))[g * 64 + tid] = pw[16 * 64 + tid];
    __syncthreads();
}

__device__ __forceinline__ void ssm_unit(const Args& a, LAS unsigned char* L, int unit, int tid, int lane, int wave) {
    const int b = unit >> 6, g = unit & 63, n = lane & 31, hh = lane >> 5;
    unsigned char* ws = a.ws;
    constexpr int TT = 0, UB0 = 16384, UBS = 32 * 528, EP = UB0 + 2 * UBS, SI = EP + 2 * 32 * 129 * 4, SIS = 272;
    static_assert(SI + 32 * SIS <= RING_BYTES, "ssm LDS map");
    const bf16* Ug = (const bf16*)(ws + WS_U) + (size_t)(b * 64 + g) * 8192 * 16;
    bf16* Yg = (bf16*)(ws + WS_Y) + (size_t)(b * 64 + g) * 8192 * 16;
    { const v4u* src = (const v4u*)(ws + WS_TTAB) + g * 1024;
#pragma unroll
      for (int i = 0; i < 2; ++i) ((LAS v4u*)(L + TT))[tid + 512 * i] = src[tid + 512 * i]; }
    bf16x8_t Ffr[8], Gfr[8];
    { const bf16x8_t* fs = (const bf16x8_t*)(ws + WS_FTAB) + ((size_t)g * 4096 + ((wave & 3) * 16 + (wave >> 2) * 8) * 64 + lane);
#pragma unroll
      for (int i = 0; i < 8; ++i) Ffr[i] = fs[i * 64];
      const bf16x8_t* gs = (const bf16x8_t*)(ws + WS_GTAB) + ((size_t)g * 4096 + (wave * 8) * 64 + lane);
#pragma unroll
      for (int kk = 0; kk < 8; ++kk) Gfr[kk] = gs[kk * 64]; }
    const f32x2v aL = ((const f32x2v*)(ws + WS_AL))[g * 64 + lane];
    float dlo[4], dhi[4];
#pragma unroll
    for (int i = 0; i < 4; ++i) { dlo[i] = a.in[8][g * 16 + 4 * hh + i]; dhi[i] = a.in[8][g * 16 + 8 + 4 * hh + i]; }
    v4u pre[2];
#pragma unroll
    for (int i = 0; i < 2; ++i) { const int q = tid + 512 * i; pre[i] = *(const v4u*)(Ug + (size_t)q * 8); }
#pragma unroll
    for (int i = 0; i < 2; ++i) { const int q = tid + 512 * i; *(LAS v4u*)(L + UB0 + (q >> 5) * 528 + (q & 31) * 16) = pre[i]; }
    __syncthreads();
    float sr = 0.f, si = 0.f;
    const int kh = wave >> 2, pb = wave & 3;
    for (int cb = 0; cb < 16; ++cb) {
        const int ub = UB0 + (cb & 1) * UBS, ubn = UB0 + ((cb & 1) ^ 1) * UBS;
        if (cb + 1 < 16) {
#pragma unroll
            for (int i = 0; i < 2; ++i) pre[i] = *(const v4u*)(Ug + (size_t)(cb + 1) * 8192 + (size_t)(tid + 512 * i) * 8); }
        f32x16 acc;
#pragma unroll
        for (int i = 0; i < 16; ++i) acc[i] = 0.f;
#pragma unroll
        for (int i = 0; i < 8; ++i) { const bf16x8_t Bf = *(const LAS bf16x8_t*)(L + ub + n * 528 + (8 * kh + i) * 32 + hh * 16); acc = __builtin_amdgcn_mfma_f32_32x32x16_bf16(Ffr[i], Bf, acc, 0, 0, 0); }
        { LAS float* ep = (LAS float*)(L + EP) + (kh * 32 + n) * 129 + 32 * pb + 4 * hh;
#pragma unroll
          for (int i = 0; i < 16; ++i) ep[(i & 3) + 8 * (i >> 2)] = acc[i]; }
        __syncthreads();
        if (wave == 0) {
            const LAS float* ep = (const LAS float*)(L + EP); LAS bf16* sip = (LAS bf16*)(L + SI);
#pragma unroll 8
            for (int c = 0; c < 32; ++c) {
                const float er = ep[c * 129 + lane] + ep[(32 + c) * 129 + lane], ei = ep[c * 129 + 64 + lane] + ep[(32 + c) * 129 + 64 + lane];
                sip[c * 136 + lane] = (bf16)f2bf(sr); sip[c * 136 + 64 + lane] = (bf16)f2bf(si);
                const float nr = aL.x * sr - aL.y * si + er, ni = aL.x * si + aL.y * sr + ei; sr = nr; si = ni; }
        }
#pragma unroll
        for (int i = 0; i < 16; ++i) acc[i] = 0.f;
        for (int j = 0; j < 2 * wave + 2; ++j) { const bf16x8_t Tf = *(const LAS bf16x8_t*)(L + TT + (2 * wave - j + 1) * 1024 + lane * 16);
            const bf16x8_t Bf = *(const LAS bf16x8_t*)(L + ub + n * 528 + j * 32 + hh * 16); acc = __builtin_amdgcn_mfma_f32_32x32x16_bf16(Tf, Bf, acc, 0, 0, 0); }
        if (cb + 1 < 16) {
#pragma unroll
            for (int i = 0; i < 2; ++i) { const int q = tid + 512 * i; *(LAS v4u*)(L + ubn + (q >> 5) * 528 + (q & 31) * 16) = pre[i]; } }
        __syncthreads();
#pragma unroll
        for (int kk = 0; kk < 8; ++kk) { const bf16x8_t Sf = *(const LAS bf16x8_t*)(L + SI + n * SIS + (16 * kk + 8 * hh) * 2); acc = __builtin_amdgcn_mfma_f32_32x32x16_bf16(Gfr[kk], Sf, acc, 0, 0, 0); }
#pragma unroll
        for (int q4 = 0; q4 < 4; ++q4) { const int t = 2 * wave + (q4 >> 1), hb = 8 * (q4 & 1) + 4 * hh;
            const v2u uu = *(const LAS v2u*)(L + ub + n * 528 + t * 32 + hb * 2);
            const float u0 = pg8::bf_lo(uu.x), u1 = pg8::bf_hi(uu.x), u2 = pg8::bf_lo(uu.y), u3 = pg8::bf_hi(uu.y);
            const float d0 = (q4 & 1) ? dhi[0] : dlo[0], d1 = (q4 & 1) ? dhi[1] : dlo[1], d2 = (q4 & 1) ? dhi[2] : dlo[2], d3 = (q4 & 1) ? dhi[3] : dlo[3];
            v2u o; o.x = pg8::cvt_pk_bf16(pg8::gelu_f(acc[4 * q4 + 0] + d0 * u0), pg8::gelu_f(acc[4 * q4 + 1] + d1 * u1));
            o.y = pg8::cvt_pk_bf16(pg8::gelu_f(acc[4 * q4 + 2] + d2 * u2), pg8::gelu_f(acc[4 * q4 + 3] + d3 * u3));
            *(v2u*)(Yg + ((size_t)(cb * 512 + n * 16 + t)) * 16 + hb) = o; }
    }
    __syncthreads();
}

__device__ __forceinline__ v4i16_t vtr16(unsigned addr) { return __builtin_amdgcn_ds_read_tr16_b64_v4i16((LAS v4i16_t*)(uintptr_t)addr); }
__device__ __forceinline__ void attn_unit(const Args& a, LAS unsigned char* L, int unit, int tid, int lane, int wave) {
    const int kvh = unit & 3, nb = (unit >> 2) & 63, b = unit >> 8;
    constexpr int KL = 0, VL = 32768, BT = 65536;
    unsigned char* ws = a.ws;
    const bf16* Q = (const bf16*)(ws + WS_Q); const bf16* Kb = (const bf16*)(ws + WS_K); const bf16* Vb = (const bf16*)(ws + WS_V);
    const bf16* ZA = (const bf16*)(ws + WS_ZA); bf16* HA = (bf16*)(ws + WS_HA);
    const size_t row0 = (size_t)b * 8192 + (size_t)nb * 128;
#pragma unroll
    for (int i = 0; i < 4; ++i) { const int q = tid + 512 * i, key = q >> 3, c = q & 7; const bool valid = (nb > 0) || (key >= 128);
        v4u kv = (v4u){0u, 0u, 0u, 0u}, vv = (v4u){0u, 0u, 0u, 0u};
        if (valid) { const size_t off = (row0 + key - 128) * 256 + kvh * 64 + 8 * c; kv = *(const v4u*)(Kb + off); vv = *(const v4u*)(Vb + off); }
        *(LAS v4u*)(L + KL + key * 128 + ((c ^ ((key >> 1) & 7)) << 4)) = kv;
        *(LAS v4u*)(L + VL + key * 128 + ((c * 16) ^ (((key >> 1) & 1) << 6))) = vv; }
    for (int idx = tid; idx < 4 * 192; idx += 512) { const int hl = idx / 192, e = idx - hl * 192, dist = e - 32;
        ((LAS float*)(L + BT))[idx] = (dist >= 0 && dist < 128) ? ((const float*)(ws + WS_BIAS))[(kvh * 4 + hl) * 128 + dist] : -1e30f; }
    __syncthreads();
    const int hl = wave >> 1, hq = kvh * 4 + hl, ql = lane & 31, hh = lane >> 5;
    const float sink2 = a.in[11][hq] * LOG2E;
    const LAS float* bt = (const LAS float*)(L + BT) + hl * 192;
    const unsigned vbase = (unsigned)(uintptr_t)(L + VL);
    for (int qi = 0; qi < 2; ++qi) {
        const int qt = 2 * (wave & 1) + qi;
        const size_t qrow = row0 + 32 * qt + ql;
        bf16x8_t qf[4];
#pragma unroll
        for (int ks = 0; ks < 4; ++ks) qf[ks] = *(const bf16x8_t*)(Q + qrow * 1024 + hq * 64 + 16 * ks + 8 * hh);
        f32x16 s[5];
#pragma unroll
        for (int t5 = 0; t5 < 5; ++t5) { const int kt = qt + t5;
            if (nb == 0 && kt < 4) {
#pragma unroll
                for (int i = 0; i < 16; ++i) s[t5][i] = -1e30f;
            } else {
#pragma unroll
                for (int i = 0; i < 16; ++i) { const int keyl = (i & 3) + 8 * (i >> 2) + 4 * hh; s[t5][i] = bt[160 - 32 * t5 + ql - keyl]; }
                const int key = 32 * kt + ql;
#pragma unroll
                for (int ks = 0; ks < 4; ++ks) { const bf16x8_t Kf = *(const LAS bf16x8_t*)(L + KL + key * 128 + (((2 * ks + hh) ^ ((key >> 1) & 7)) << 4));
                    s[t5] = __builtin_amdgcn_mfma_f32_32x32x16_bf16(Kf, qf[ks], s[t5], 0, 0, 0); }
            } }
        float mx = s[0][0];
#pragma unroll
        for (int t5 = 0; t5 < 5; ++t5)
#pragma unroll
            for (int i = 0; i < 16; ++i) mx = fmaxf(mx, s[t5][i]);
        mx = fmaxf(mx, __shfl_xor(mx, 32)); mx = fmaxf(mx, sink2);
        float ls = 0.f;
#pragma unroll
        for (int t5 = 0; t5 < 5; ++t5)
#pragma unroll
            for (int i = 0; i < 16; ++i) { const float p = __builtin_amdgcn_exp2f(s[t5][i] - mx); s[t5][i] = p; ls += p; }
        ls += __shfl_xor(ls, 32); ls += __builtin_amdgcn_exp2f(sink2 - mx);
        f32x16 o[2];
#pragma unroll
        for (int i = 0; i < 16; ++i) { o[0][i] = 0.f; o[1][i] = 0.f; }
        const int gi = lane >> 4, i_ = lane & 15;
#pragma unroll
        for (int t5 = 0; t5 < 5; ++t5)
#pragma unroll
            for (int sst = 0; sst < 2; ++sst) { const int kt = qt + t5;
                pg8::u32x4 pw4; pw4.x = pg8::cvt_pk_bf16(s[t5][8 * sst + 0], s[t5][8 * sst + 1]); pw4.y = pg8::cvt_pk_bf16(s[t5][8 * sst + 2], s[t5][8 * sst + 3]);
                pw4.z = pg8::cvt_pk_bf16(s[t5][8 * sst + 4], s[t5][8 * sst + 5]); pw4.w = pg8::cvt_pk_bf16(s[t5][8 * sst + 6], s[t5][8 * sst + 7]);
                const bf16x8_t Pf = __builtin_bit_cast(bf16x8_t, pw4);
                const int key = 32 * kt + 16 * sst + 4 * hh + (i_ >> 2);
                const unsigned rowa = vbase + key * 128, sw = ((key >> 1) & 1) << 6;
#pragma unroll
                for (int db = 0; db < 2; ++db) { const unsigned cb_ = (unsigned)(64 * db + 32 * (gi & 1) + 8 * (i_ & 3));
                    const v4i16_t lo = vtr16(rowa + (cb_ ^ sw)), hi = vtr16(rowa + 8 * 128 + (cb_ ^ sw));
                    const bf16x8_t Vf = (bf16x8_t){lo[0], lo[1], lo[2], lo[3], hi[0], hi[1], hi[2], hi[3]};
                    o[db] = __builtin_amdgcn_mfma_f32_32x32x16_bf16(Vf, Pf, o[db], 0, 0, 0); } }
        const float rl = 1.0f / ls;
#pragma unroll
        for (int db = 0; db < 2; ++db)
#pragma unroll
            for (int g4 = 0; g4 < 4; ++g4) { const size_t off = qrow * 1024 + hq * 64 + 32 * db + 8 * g4 + 4 * hh; const v2u z = *(const v2u*)(ZA + off);
                v2u w; w.x = pg8::cvt_pk_bf16(o[db][4 * g4 + 0] * rl * pg8::bf_lo(z.x), o[db][4 * g4 + 1] * rl * pg8::bf_hi(z.x));
                w.y = pg8::cvt_pk_bf16(o[db][4 * g4 + 2] * rl * pg8::bf_lo(z.y), o[db][4 * g4 + 3] * rl * pg8::bf_hi(z.y)); *(v2u*)(HA + off) = w; }
    }
    __syncthreads();
}

__device__ __forceinline__ float wave_sum(float v) {
#pragma unroll
    for (int o = 1; o < 64; o <<= 1) v += __shfl_xor(v, o);
    return v;
}

__global__ void __launch_bounds__(NWAVES * 64, 2) fwd_megakernel(Args args) {
    extern __shared__ __attribute__((aligned(16))) unsigned char lds[];
    cg::grid_group grid = cg::this_grid();
    const int tid = threadIdx.x, lane = tid & 63, wave = __builtin_amdgcn_readfirstlane(tid >> 6);
    const int G = gridDim.x, bx = blockIdx.x;
    const int vcu = (G % 8 == 0) ? (bx % 8) * (G / 8) + bx / 8 : bx;
    unsigned char* ws = args.ws;
    const int lo = args.ph_lo, hi = args.ph_hi;
#define IN(k) (lo <= (k) && (k) < hi)
#define SEAM(k) do { if (IN(k) && IN((k) + 1)) xcd_barrier(xbar); } while (0)
    LAS unsigned char* ldsl = (LAS unsigned char*)lds;
    volatile LAS unsigned* xst = (volatile LAS unsigned*)(ldsl + RING_BYTES);
    if (tid < 2) xst[tid] = 0u;
    unsigned* xwords = (unsigned*)(ws + WS_XBAR);
    XcdBarrier xbar; xbar.bar = xwords; xbar.x = 0; xbar.st = xst;
    const int gw = vcu * NWAVES + wave, NGW = G * NWAVES;
    const int gt = vcu * (NWAVES * 64) + tid, NGT = G * NWAVES * 64;

    if (IN(0)) {
        { const float* x = args.in[0]; bf16* xb = (bf16*)(ws + WS_XB);
          for (size_t i = (size_t)gt; i < (size_t)M * DM / 8; i += NGT) { const f32x4 a = *(const f32x4*)(x + i * 8), b = *(const f32x4*)(x + i * 8 + 4);
              v4u o; o.x = pk2(a[0], a[1]); o.y = pk2(a[2], a[3]); o.z = pk2(b[0], b[1]); o.w = pk2(b[2], b[3]); *(v4u*)(xb + i * 8) = o; } }
        { LAS float* scr = (LAS float*)(ldsl + wave * 16384);
          constexpr int I_IN = (DM / 64) * (D_IN / 32), I_GLU = (D_SSM / 64) * (2048 / 32), I_BS = I_GLU, I_BA = I_GLU, I_OUT = (DM / 64) * (DM / 32);
          constexpr int NITEMS = I_IN + I_GLU + I_BS + I_BA + I_OUT;
          for (int it = gw; it < NITEMS; it += NGW) {
              int r = it;
              if (r < I_IN) { const int nblk = D_IN / 32, kb = r / nblk, nb = r % nblk; p0_transpose_item(args.in[1], DM, D_IN, (bf16*)(ws + WS_WIN), 64 * kb, 32 * nb, 32 * nb, scr, lane); continue; } r -= I_IN;
              if (r < I_GLU) { const int nblk = 2048 / 32, kb = r / nblk, nb = r % nblk, n0 = 32 * nb;
                  const int wrow = 256 * ((n0 & 1023) >> 7) + 128 * (n0 >> 10) + (n0 & 127);
                  p0_transpose_item(args.in[10], D_SSM, 2048, (bf16*)(ws + WS_WGLU), 64 * kb, n0, wrow, scr, lane); continue; } r -= I_GLU;
              if (r < I_BS) { const int nblk = 2048 / 32, kb = r / nblk, nb = r % nblk; p0_transpose_item(args.in[13], D_SSM, DM, (bf16*)(ws + WS_WBS), 64 * kb, 32 * nb, 32 * nb, scr, lane); continue; } r -= I_BS;
              if (r < I_BA) { const int nblk = 2048 / 32, kb = r / nblk, nb = r % nblk; p0_transpose_item(args.in[14], D_ATTN, DM, (bf16*)(ws + WS_WBA), 64 * kb, 32 * nb, 32 * nb, scr, lane); continue; } r -= I_BA;
              { const int nblk = DM / 32, kb = r / nblk, nb = r % nblk; p0_transpose_item(args.in[15], DM, DM, (bf16*)(ws + WS_WOUT), 64 * kb, 32 * nb, 32 * nb, scr, lane); }
          } }
        if (gt < 16 * 128) { const int h = gt >> 7, dist = gt & 127; ((float*)(ws + WS_BIAS))[gt] = args.in[12][t5_bucket(dist) * 16 + h] * LOG2E; }
        __syncthreads();
#if !SIMPLE_SSM
        for (int tg = vcu; tg < 256; tg += G) ssm_tables(args, ldsl, tg, tid);
#endif
    }
    if (IN(0) && IN(1)) {
        if (bx == 0) { for (int i = tid; i < XCD_BAR_WORDS; i += NWAVES * 64) __hip_atomic_store(xwords + i, 0u, __ATOMIC_RELAXED, __HIP_MEMORY_SCOPE_AGENT); }
        grid.sync();
        xbar = xcd_barrier_post(xwords, xst);
    }

    if (IN(1)) {
        pg8::Gemm g{(const bf16*)(ws + WS_XB), (const bf16*)(ws + WS_WIN), DM, 0}; pg8::StaticOrder S; S.init(M, D_IN, G, bx);
        pg8::EpiInProj E{(bf16*)(ws + WS_U), (bf16*)(ws + WS_ZS), (bf16*)(ws + WS_Q), (bf16*)(ws + WS_K), (bf16*)(ws + WS_V), (bf16*)(ws + WS_ZA), (bf16*)(ws + WS_GS), (bf16*)(ws + WS_GA)};
        pg8::gemm_phase<pg8::EpiInProj, pg8::StaticOrder, true, true>(ldsl, g, S, E);
    }
    SEAM(1);

    if (IN(2)) {
#if SIMPLE_SSM
        if (wave == 0) { for (int unit = vcu; unit < BATCH * NG; unit += G) ssm_simple_unit(args, unit, lane); }
#else
        for (int unit = vcu; unit < BATCH * NG; unit += G) ssm_unit(args, ldsl, unit, tid, lane, wave);
#endif
#if SIMPLE_ATTN
        { const int at = vcu * 512 + tid, NAT = G * 512; for (int item = at; item < M * NQH; item += NAT) attn_simple_item(args, item); }
#else
        for (int unit = vcu; unit < BATCH * 64 * NKVH; unit += G) attn_unit(args, ldsl, unit, tid, lane, wave);
#endif
        __syncthreads();
    }
    SEAM(2);

    if (IN(3)) {
        pg8::Gemm g{(const bf16*)(ws + WS_Y), (const bf16*)(ws + WS_WGLU), D_SSM, 1}; pg8::StaticOrder S; S.init(M, 2048, G, bx);
        pg8::EpiGlu E{(const bf16*)(ws + WS_ZS), (bf16*)(ws + WS_Q)};
        pg8::gemm_phase<pg8::EpiGlu, pg8::StaticOrder, true, true>(ldsl, g, S, E);
    }
    SEAM(3);

    if (IN(4)) {
        pg8::Gemm g{(const bf16*)(ws + WS_Q), (const bf16*)(ws + WS_WBS), D_SSM, 0}; pg8::StaticOrder S; S.init(M, DM, G, bx);
        pg8::EpiGate<false> E{(const bf16*)(ws + WS_GS), (bf16*)(ws + WS_XB)};
        pg8::gemm_phase<pg8::EpiGate<false>, pg8::StaticOrder, true, true>(ldsl, g, S, E);
    }
    SEAM(4);

    if (IN(5)) {
        pg8::Gemm g{(const bf16*)(ws + WS_HA), (const bf16*)(ws + WS_WBA), D_ATTN, 0}; pg8::StaticOrder S; S.init(M, DM, G, bx);
        pg8::EpiGate<true> E{(const bf16*)(ws + WS_GA), (bf16*)(ws + WS_XB)};
        pg8::gemm_phase<pg8::EpiGate<true>, pg8::StaticOrder, true, true>(ldsl, g, S, E);
    }
    SEAM(5);

    if (IN(6)) {
        pg8::Gemm g{(const bf16*)(ws + WS_XB), (const bf16*)(ws + WS_WOUT), DM, 0}; pg8::StaticOrder S; S.init(M, DM, G, bx);
        pg8::EpiResid E{args.in[0], args.out};
        pg8::gemm_phase<pg8::EpiResid, pg8::StaticOrder, true, true>(ldsl, g, S, E);
    }
    SEAM(6);

    if (IN(7)) {
        const float* gain = args.in[16]; const float* bias = args.in[17];
        for (int m = gw; m < M; m += NGW) {
            GAS f32x4* xr = (GAS f32x4*)(args.out + (size_t)m * DM) + lane;
            f32x4 v[8]; float s = 0.f;
#pragma unroll
            for (int j = 0; j < 8; ++j) { v[j] = xr[64 * j]; s += (v[j].x + v[j].y) + (v[j].z + v[j].w); }
            const float mean = wave_sum(s) * (1.f / DM); float s2 = 0.f;
#pragma unroll
            for (int j = 0; j < 8; ++j) { v[j] = v[j] - mean; s2 += (v[j].x * v[j].x + v[j].y * v[j].y) + (v[j].z * v[j].z + v[j].w * v[j].w); }
            const float rstd = 1.f / sqrtf(wave_sum(s2) * (1.f / DM) + LN_EPS);
#pragma unroll
            for (int j = 0; j < 8; ++j) { const f32x4 gn = *(const f32x4*)(gain + (64 * j + lane) * 4), bs = *(const f32x4*)(bias + (64 * j + lane) * 4); xr[64 * j] = v[j] * rstd * gn + bs; }
        }
    }
#undef IN
#undef SEAM
}

extern "C" void kernel_launch(void* const* d_in, const int* in_sizes, int n_in, void* d_out, int out_size, void* d_ws, size_t ws_size, hipStream_t stream) {
    static int grid = 0;
    if (grid == 0) {
        if (n_in != 18 || in_sizes[0] != M * DM || out_size != M * DM || ws_size < WS_END) { fprintf(stderr, "kernel_launch: unexpected shapes (n_in %d, in0 %d, out %d, ws %zu); nothing launched\n", n_in, n_in > 0 ? in_sizes[0] : -1, out_size, ws_size); grid = -1; return; }
        int dev = 0, cus = 0, per_cu = 0;
        if (hipGetDevice(&dev) != hipSuccess || hipDeviceGetAttribute(&cus, hipDeviceAttributeMultiprocessorCount, dev) != hipSuccess) { grid = -1; return; }
        if (hipFuncSetAttribute((const void*)fwd_megakernel, hipFuncAttributeMaxDynamicSharedMemorySize, LDS_BYTES) != hipSuccess) { fprintf(stderr, "kernel_launch: hipFuncSetAttribute failed\n"); grid = -1; return; }
        if (hipOccupancyMaxActiveBlocksPerMultiprocessor(&per_cu, (const void*)fwd_megakernel, NWAVES * 64, LDS_BYTES) != hipSuccess || per_cu < 1) { fprintf(stderr, "kernel_launch: occupancy query says %d\n", per_cu); per_cu = 1; }
        (void)hipGetLastError();
        grid = cus * 1;
    }
    if (grid < 0) return;
    Args a{};
    for (int i = 0; i < 18; ++i) a.in[i] = (const float*)d_in[i];
    a.out = (float*)d_out; a.ws = (unsigned char*)d_ws;
#if MK_N_LAUNCHES == 1
    a.ph_lo = 0; a.ph_hi = N_PHASES;
    void* kargs[] = {&a};
    hipError_t e = hipLaunchCooperativeKernel((const void*)fwd_megakernel, dim3(grid), dim3(NWAVES * 64), kargs, LDS_BYTES, stream);
    if (e != hipSuccess) fprintf(stderr, "cooperative launch failed: %s (grid %d)\n", hipGetErrorString(e), grid);
#else
    for (int p = 0; p < N_PHASES; ++p) { a.ph_lo = p; a.ph_hi = p + 1; hipLaunchKernelGGL(fwd_megakernel, dim3(grid), dim3(NWAVES * 64), LDS_BYTES, stream, a); }
#endif
}
```
